# Optimizing an MI355X kernel written in HIP

```python
import math
import jax, jax.numpy as jnp
from jax import lax
import numpy as np

D_MODEL = 1024
BATCH = 16
SEQ = 4096
DEPTH = 4

N_MIXERS = 2
PLE_DIM = 256
FFN_HIDDEN = ((8 * D_MODEL // 3 + 255) // 256) * 256
DA_HEADS = 8
DA_HEAD_DIM = D_MODEL // (2 * DA_HEADS)
Q_BLOCK = 128
NA_HEADS = 16
NA_HEAD_DIM = D_MODEL // NA_HEADS
GRID_W = 64
NA_KR = 8
NA_KC = 16
NORM_EPS = 1e-6
SUBLN_EPS = 1e-5

kernel_name = "hybrid_diffattn_natten_encoder"


def rmsnorm(x, g, eps=NORM_EPS):
    xf = x.astype(jnp.float32)
    y = xf * lax.rsqrt(jnp.mean(xf * xf, axis=-1, keepdims=True) + eps)
    return (y * g.astype(jnp.float32)).astype(x.dtype)


def alibi_slopes(n_heads):
    return jnp.array([2.0 ** (-8.0 * (h + 1) / n_heads) for h in range(n_heads)], dtype=jnp.float32)


def diff_attention(h, w_qkv, w_o, lq1, lk1, lq2, lk2, subln, layer_idx):
    B, S, _ = h.shape
    qkv = h @ w_qkv
    q, k, v = jnp.split(qkv, 3, axis=-1)
    q = q.reshape(B, S, DA_HEADS, 2, DA_HEAD_DIM).transpose(3, 0, 2, 1, 4)
    k = k.reshape(B, S, DA_HEADS, 2, DA_HEAD_DIM).transpose(3, 0, 2, 1, 4)
    v = v.reshape(B, S, DA_HEADS, 2 * DA_HEAD_DIM).transpose(0, 2, 1, 3)
    lam_init = 0.8 - 0.6 * math.exp(-0.3 * layer_idx)
    lam = (jnp.exp(jnp.sum(lq1.astype(jnp.float32) * lk1.astype(jnp.float32)))
           - jnp.exp(jnp.sum(lq2.astype(jnp.float32) * lk2.astype(jnp.float32)))
           + lam_init)
    slopes = alibi_slopes(DA_HEADS)
    scale = DA_HEAD_DIM ** -0.5
    nblk = S // Q_BLOCK
    qb = q.reshape(2, B, DA_HEADS, nblk, Q_BLOCK, DA_HEAD_DIM).transpose(3, 0, 1, 2, 4, 5)
    kpos = jnp.arange(S)

    def block(args):
        qblk, bi = args
        qpos = bi * Q_BLOCK + jnp.arange(Q_BLOCK)
        dist = jnp.abs(qpos[:, None] - kpos[None, :]).astype(jnp.float32)
        bias = -slopes[:, None, None] * dist
        s = jnp.einsum('mbhqd,mbhkd->mbhqk', qblk, k).astype(jnp.float32) * scale + bias
        a = jax.nn.softmax(s, axis=-1)
        a = a[0] - lam * a[1]
        return jnp.einsum('bhqk,bhkd->bhqd', a.astype(v.dtype), v)

    o = lax.map(block, (qb, jnp.arange(nblk)))
    o = o.transpose(1, 0, 3, 2, 4).reshape(B, S, DA_HEADS, 2 * DA_HEAD_DIM)
    o = rmsnorm(o, subln, eps=SUBLN_EPS) * (1.0 - lam_init)
    return o.reshape(B, S, D_MODEL) @ w_o


def neighborhood_attention(h, w_qkv, b_qkv, rpb, w_o):
    B, S, _ = h.shape
    rows = S // GRID_W
    kr = min(NA_KR, rows)
    W = GRID_W
    qkv = h @ w_qkv + b_qkv
    qkv = qkv.reshape(B, rows, W, 3, NA_HEADS, NA_HEAD_DIM).transpose(3, 0, 4, 1, 2, 5)
    q = qkv[0] * (NA_HEAD_DIM ** -0.5)
    k = qkv[1]
    v = qkv[2]
    cols = jnp.arange(W)
    cstart = jnp.clip(cols - NA_KC // 2, 0, W - NA_KC)
    col_mask = (cols[None, :] >= cstart[:, None]) & (cols[None, :] < cstart[:, None] + NA_KC)
    col_off = jnp.clip(cols[None, :] - cols[:, None], -(NA_KC - 1), NA_KC - 1) + (NA_KC - 1)
    rpb_cols = rpb[:, :, col_off]
    key_mask = jnp.tile(col_mask, (1, kr))

    def row_block(r):
        rs = jnp.clip(r - kr // 2, 0, rows - kr)
        kb = lax.dynamic_slice_in_dim(k, rs, kr, axis=2).reshape(B, NA_HEADS, kr * W, NA_HEAD_DIM)
        vb = lax.dynamic_slice_in_dim(v, rs, kr, axis=2).reshape(B, NA_HEADS, kr * W, NA_HEAD_DIM)
        qr = lax.dynamic_index_in_dim(q, r, axis=2, keepdims=False)
        row_off = rs + jnp.arange(kr) - r + (NA_KR - 1)
        bias = jnp.take(rpb_cols, row_off, axis=1)
        bias = bias.transpose(0, 2, 1, 3).reshape(NA_HEADS, W, kr * W).astype(jnp.float32)
        s = jnp.einsum('bhqd,bhkd->bhqk', qr, kb).astype(jnp.float32) + bias
        s = jnp.where(key_mask, s, -jnp.inf)
        a = jax.nn.softmax(s, axis=-1)
        return jnp.einsum('bhqk,bhkd->bhqd', a.astype(vb.dtype), vb)

    o = lax.map(row_block, jnp.arange(rows))
    o = o.transpose(1, 0, 3, 2, 4).reshape(B, S, D_MODEL)
    return o @ w_o


def swiglu(h, w_gate, w_up, w_down):
    return (jax.nn.silu(h @ w_gate) * (h @ w_up)) @ w_down


def setup_inputs(seed: int = 0) -> dict:
    key = jax.random.key(seed)
    ks = jax.random.split(key, 24)
    n_a = (DEPTH + 1) // 2
    n_b = DEPTH // 2
    D, F = D_MODEL, FFN_HIDDEN
    f32 = jnp.float32

    def nrm(k, shape, scale):
        return jax.random.normal(k, shape, f32) * scale

    return {
        "x": nrm(ks[0], (BATCH, SEQ, D), 1.0),
        "p": nrm(ks[1], (DEPTH, BATCH, SEQ, PLE_DIM), 1.0),
        "norm_mix": 1.0 + nrm(ks[2], (DEPTH, D), 0.05),
        "norm_ffn": 1.0 + nrm(ks[3], (DEPTH, D), 0.05),
        "norm_ple": 1.0 + nrm(ks[4], (DEPTH, D), 0.05),
        "norm_final": 1.0 + nrm(ks[5], (D,), 0.05),
        "da_w_qkv": nrm(ks[6], (n_a, D, 3 * D), D ** -0.5),
        "da_w_o": nrm(ks[7], (n_a, D, D), D ** -0.5),
        "da_lambda_q1": nrm(ks[8], (n_a, DA_HEAD_DIM), 0.1),
        "da_lambda_k1": nrm(ks[9], (n_a, DA_HEAD_DIM), 0.1),
        "da_lambda_q2": nrm(ks[10], (n_a, DA_HEAD_DIM), 0.1),
        "da_lambda_k2": nrm(ks[11], (n_a, DA_HEAD_DIM), 0.1),
        "da_subln": 1.0 + nrm(ks[12], (n_a, 2 * DA_HEAD_DIM), 0.05),
        "na_w_qkv": nrm(ks[13], (n_b, D, 3 * D), D ** -0.5),
        "na_b_qkv": nrm(ks[14], (n_b, 3 * D), 0.02),
        "na_rpb": nrm(ks[15], (n_b, NA_HEADS, 2 * NA_KR - 1, 2 * NA_KC - 1), 0.5),
        "na_w_o": nrm(ks[16], (n_b, D, D), D ** -0.5),
        "ffn_w_gate": nrm(ks[17], (DEPTH, D, F), D ** -0.5),
        "ffn_w_up": nrm(ks[18], (DEPTH, D, F), D ** -0.5),
        "ffn_w_down": nrm(ks[19], (DEPTH, F, D), F ** -0.5),
        "ple_w_proj": nrm(ks[20], (DEPTH, PLE_DIM, D), PLE_DIM ** -0.5),
        "ple_w_gate": nrm(ks[21], (DEPTH, D, D), D ** -0.5),
    }


def reference(x, p, norm_mix, norm_ffn, norm_ple, norm_final,
              da_w_qkv, da_w_o, da_lambda_q1, da_lambda_k1, da_lambda_q2, da_lambda_k2, da_subln,
              na_w_qkv, na_b_qkv, na_rpb, na_w_o,
              ffn_w_gate, ffn_w_up, ffn_w_down, ple_w_proj, ple_w_gate):
    h = x
    for i in range(DEPTH):
        hn = rmsnorm(h, norm_mix[i])
        j = i // N_MIXERS
        if i % N_MIXERS == 0:
            mix = diff_attention(hn, da_w_qkv[j], da_w_o[j], da_lambda_q1[j], da_lambda_k1[j],
                                 da_lambda_q2[j], da_lambda_k2[j], da_subln[j], i)
        else:
            mix = neighborhood_attention(hn, na_w_qkv[j], na_b_qkv[j], na_rpb[j], na_w_o[j])
        h = h + mix
        h = h + swiglu(rmsnorm(h, norm_ffn[i]), ffn_w_gate[i], ffn_w_up[i], ffn_w_down[i])
        gate = jax.nn.sigmoid(rmsnorm(h, norm_ple[i]) @ ple_w_gate[i])
        h = h + gate * (p[i] @ ple_w_proj[i])
    return rmsnorm(h, norm_final)
```

```cpp
#ifndef GQ
#define GQ(...) __VA_ARGS__
#endif
#ifndef GV
#define GV(...) __VA_ARGS__
#endif
#ifndef GR
#define GR(...) __VA_ARGS__
#endif
#ifndef GS
#define GS(...) __VA_ARGS__
#endif
#ifndef GP
#define GP(...) __VA_ARGS__
#endif
#define GEMM_CALL_EpiQK(...) GQ(__VA_ARGS__)
#define GEMM_CALL_EpiVT(...) GV(__VA_ARGS__)
#define GEMM_CALL_EpiResid(...) GR(__VA_ARGS__)
#define GEMM_CALL_EpiSwiGLU(...) GS(__VA_ARGS__)
#define GEMM_CALL_EpiPle(...) GP(__VA_ARGS__)
#include <hip/hip_runtime.h>
#include <hip/hip_cooperative_groups.h>
#include <cstdio>
#include <cstdint>
namespace cg = cooperative_groups;
namespace pg8 {
#define PG8_LAS __attribute__((address_space(3)))
typedef unsigned short bf16_t;
typedef short bf16x8 __attribute__((ext_vector_type(8)));
typedef float f32x4 __attribute__((ext_vector_type(4)));
typedef unsigned u32x4 __attribute__((ext_vector_type(4)));
constexpr int BM = 256, BK = 64, HALF = 128, HTB = HALF * BK * 2  , STAGE_BYTES = 8 * HTB, NXCD = 8, WGM = 8;

__host__ __device__ __forceinline__ int lds_byte(int r, int c) { const int st = (r >> 4) * 2 + (c >> 5), rr = r & 15, cc = c & 31, ob = rr * 64 + cc * 2; return st * 1024 + (ob ^ (((ob >> 9) & 1) << 5)); }
__host__ __device__ __forceinline__ void stage_rc(int b, int& R, int& C) { const int st = b / 1024, sb = b % 1024, swz = sb ^ (((sb >> 9) & 1) << 5); R = (st >> 1) * 16 + swz / 64; C = (st & 1) * 32 + (swz % 64) / 2; }
__host__ __device__ __forceinline__ int perm32(int rho) { const int n = rho >> 4, i = rho & 15; return 8 * (i >> 2) + 4 * n + (i & 3); }

struct Unit { int pm, pn; };
struct Gemm { const bf16_t* A; const bf16_t* Bt; int M, N, K; };

struct StaticOrder {
    int nM, nN, nwg, G, c;
    __host__ __device__ void init(int M, int N, int G_, int c_) { nM = M / BM; nN = N / BM; nwg = nM * nN; G = G_; c = c_; }
    __host__ __device__ bool next(int i, Unit& u) const {
        const long L = (long)i * G + c; if (L >= nwg) return false;
        int wgid = (int)L; { const int q = nwg / NXCD, r = nwg % NXCD, xcd = wgid % NXCD, off = wgid / NXCD; wgid = (xcd < r ? xcd * (q + 1) : r * (q + 1) + (xcd - r) * q) + off; }
        const int nig = WGM * nN, gid = wgid / nig, fm = gid * WGM, gsz = (nM - fm) < WGM ? (nM - fm) : WGM;
        u.pm = fm + ((wgid % nig) % gsz); u.pn = (wgid % nig) / gsz; return true;
    }
    __device__ __forceinline__ void a_ready(const Unit&) const {}
    __device__ __forceinline__ void done(const Unit&) const {}
};

__device__ __forceinline__ unsigned cvt_pk_bf16(float lo, float hi) { unsigned r; asm volatile("v_cvt_pk_bf16_f32 %0, %1, %2" : "=v"(r) : "v"(lo), "v"(hi)); return r; }
typedef float f32x2 __attribute__((ext_vector_type(2)));
typedef unsigned u32x2 __attribute__((ext_vector_type(2)));
#define PG8_GAS __attribute__((address_space(1)))
constexpr float LOG2E = 1.4426950408889634f;
typedef unsigned long long u64;
constexpr float SSQ_FIX = 1048576.0f;
__device__ __forceinline__ float rstd_of(u64 q) { return rsqrtf((float)q * (1.0f / (SSQ_FIX * 1024.0f)) + 1e-6f); }
__device__ __forceinline__ float rstd_row(const u64* ssq, int row) { return rstd_of(((const PG8_GAS u64*)ssq)[row]); }
__device__ __forceinline__ float sigm(float a) { return __builtin_amdgcn_rcpf(1.0f + __builtin_amdgcn_exp2f(-a * LOG2E)); }
__device__ __forceinline__ void atomic_addf(u64* p, float v) { __hip_atomic_fetch_add((PG8_GAS u64*)p, (u64)(v * SSQ_FIX + 0.5f), __ATOMIC_RELAXED, __HIP_MEMORY_SCOPE_AGENT); }

struct EpiQK {
    static constexpr bool PERM = true, AFTER_DRAIN = false;
    bf16_t* O; int ldc; const u64* ssq; const float* bias; int qcols; float qscale;
    __device__ __forceinline__ void operator()(const f32x4 (&acc)[2][2][4][2], const Unit& u, int wr, int wc, int fr, int fq) const {
        const int row0 = u.pm * BM + wr * 64 + fr, col0 = u.pn * BM + wc * 32 + 8 * fq;
        const float sc = (u.pn * BM < qcols) ? qscale : 1.f;
        f32x4 bv[2][2];
#pragma unroll
        for (int bj = 0; bj < 2; ++bj)
#pragma unroll
            for (int n = 0; n < 2; ++n) bv[bj][n] = bias ? *(const PG8_GAS f32x4*)(bias + col0 + bj * HALF + 4 * n) : (f32x4){0.f, 0.f, 0.f, 0.f};
#pragma unroll
        for (int ai = 0; ai < 2; ++ai)
#pragma unroll
            for (int m = 0; m < 4; ++m) { const int row = row0 + ai * HALF + m * 16; const float rs = ssq ? rstd_row(ssq, row) : 1.f; bf16_t* rowp = O + (size_t)row * ldc + col0;
#pragma unroll
                for (int bj = 0; bj < 2; ++bj) { const f32x4 v0 = (acc[ai][bj][m][0] * rs + bv[bj][0]) * sc, v1 = (acc[ai][bj][m][1] * rs + bv[bj][1]) * sc;
                    u32x4 w; w.x = cvt_pk_bf16(v0[0], v0[1]); w.y = cvt_pk_bf16(v0[2], v0[3]); w.z = cvt_pk_bf16(v1[0], v1[1]); w.w = cvt_pk_bf16(v1[2], v1[3]);
                    *(PG8_GAS u32x4*)(rowp + bj * HALF) = w; } }
    }
};
struct EpiVT {
    static constexpr bool PERM = true, AFTER_DRAIN = false;
    bf16_t* O; int ldc; const u64* ssq; const float* bias;
    __device__ __forceinline__ void operator()(const f32x4 (&acc)[2][2][4][2], const Unit& u, int wr, int wc, int fr, int fq) const {
        const int row0 = u.pm * BM + wr * 64 + fr, col0 = u.pn * BM + wc * 32 + 8 * fq;
        f32x4 rs[2][2];
#pragma unroll
        for (int bj = 0; bj < 2; ++bj)
#pragma unroll
            for (int n = 0; n < 2; ++n) {
#pragma unroll
                for (int i = 0; i < 4; ++i) rs[bj][n][i] = rstd_of(((const PG8_GAS u64*)ssq)[col0 + bj * HALF + 4 * n + i]); }
#pragma unroll
        for (int ai = 0; ai < 2; ++ai)
#pragma unroll
            for (int m = 0; m < 4; ++m) { const int row = row0 + ai * HALF + m * 16; const float bb = bias ? ((const PG8_GAS float*)bias)[row] : 0.f; bf16_t* rowp = O + (size_t)row * ldc + col0;
#pragma unroll
                for (int bj = 0; bj < 2; ++bj) { const f32x4 v0 = acc[ai][bj][m][0] * rs[bj][0] + bb, v1 = acc[ai][bj][m][1] * rs[bj][1] + bb;
                    u32x4 w; w.x = cvt_pk_bf16(v0[0], v0[1]); w.y = cvt_pk_bf16(v0[2], v0[3]); w.z = cvt_pk_bf16(v1[0], v1[1]); w.w = cvt_pk_bf16(v1[2], v1[3]);
                    *(PG8_GAS u32x4*)(rowp + bj * HALF) = w; } }
    }
};
struct EpiResid {
    static constexpr bool PERM = false, AFTER_DRAIN = false;
    const float* base; float* out; bf16_t* hb; u64* ssq_next;
    __device__ __forceinline__ void operator()(const f32x4 (&acc)[2][2][4][2], const Unit& u, int wr, int wc, int fr, int fq) const {
        const int row0 = u.pm * BM + wr * 64 + fr, col0 = u.pn * BM + wc * 32 + 4 * fq;
#pragma unroll
        for (int am = 0; am < 4; ++am) { const int ai = am >> 1, m0 = (am & 1) * 2;
            f32x4 bs[4][2][2];
#pragma unroll
            for (int m = m0; m < m0 + 2; ++m) { const size_t off0 = (size_t)(row0 + ai * HALF + m * 16) * 1024 + col0;
#pragma unroll
                for (int bj = 0; bj < 2; ++bj)
#pragma unroll
                    for (int n = 0; n < 2; ++n) bs[m][bj][n] = *(const PG8_GAS f32x4*)(base + off0 + bj * HALF + n * 16); }
            asm volatile("" ::: "memory");
#pragma unroll
            for (int m = m0; m < m0 + 2; ++m) { const int row = row0 + ai * HALF + m * 16; const size_t off0 = (size_t)row * 1024 + col0; float ss = 0.f;
#pragma unroll
                for (int bj = 0; bj < 2; ++bj)
#pragma unroll
                    for (int n = 0; n < 2; ++n) { const size_t off = off0 + bj * HALF + n * 16; const f32x4 v = bs[m][bj][n] + acc[ai][bj][m][n];
                        *(PG8_GAS f32x4*)(out + off) = v; u32x2 w; w.x = cvt_pk_bf16(v[0], v[1]); w.y = cvt_pk_bf16(v[2], v[3]); *(PG8_GAS u32x2*)(hb + off) = w;
                        ss += (v[0] * v[0] + v[1] * v[1]) + (v[2] * v[2] + v[3] * v[3]); }
                ss += __shfl_xor(ss, 16); ss += __shfl_xor(ss, 32);
                if (fq == 0) atomic_addf(ssq_next + row, ss); }
            asm volatile("" ::: "memory");
        }
    }
};
struct EpiSwiGLU {
    static constexpr bool PERM = true, AFTER_DRAIN = false;
    bf16_t* O; const u64* ssq;
    __device__ __forceinline__ void operator()(const f32x4 (&acc)[2][2][4][2], const Unit& u, int wr, int wc, int fr, int fq) const {
        const int row0 = u.pm * BM + wr * 64 + fr, colh = u.pn * HALF + wc * 32 + 8 * fq;
#pragma unroll
        for (int ai = 0; ai < 2; ++ai)
#pragma unroll
            for (int m = 0; m < 4; ++m) { const int row = row0 + ai * HALF + m * 16; const float rs = rstd_row(ssq, row); f32x4 r[2];
#pragma unroll
                for (int n = 0; n < 2; ++n) { const f32x4 g = acc[ai][0][m][n] * rs, up = acc[ai][1][m][n] * rs;
#pragma unroll
                    for (int i = 0; i < 4; ++i) r[n][i] = g[i] * sigm(g[i]) * up[i]; }
                u32x4 w; w.x = cvt_pk_bf16(r[0][0], r[0][1]); w.y = cvt_pk_bf16(r[0][2], r[0][3]); w.z = cvt_pk_bf16(r[1][0], r[1][1]); w.w = cvt_pk_bf16(r[1][2], r[1][3]);
                *(PG8_GAS u32x4*)(O + (size_t)row * 2816 + colh) = w; }
    }
};
struct EpiPle {
    static constexpr bool PERM = false, AFTER_DRAIN = false;
    float* h; const bf16_t* proj; bf16_t* hb; const u64* ssq_in; u64* ssq_next;
    __device__ __forceinline__ void operator()(const f32x4 (&acc)[2][2][4][2], const Unit& u, int wr, int wc, int fr, int fq) const {
        const int row0 = u.pm * BM + wr * 64 + fr, col0 = u.pn * BM + wc * 32 + 4 * fq;
#pragma unroll
        for (int am = 0; am < 4; ++am) { const int ai = am >> 1, m0 = (am & 1) * 2;
            f32x4 hs[4][2][2]; u32x2 ps[4][2][2]; u64 sq[4];
#pragma unroll
            for (int m = m0; m < m0 + 2; ++m) { const int row = row0 + ai * HALF + m * 16; const size_t off0 = (size_t)row * 1024 + col0; sq[m] = ((const PG8_GAS u64*)ssq_in)[row];
#pragma unroll
                for (int bj = 0; bj < 2; ++bj)
#pragma unroll
                    for (int n = 0; n < 2; ++n) { hs[m][bj][n] = *(const PG8_GAS f32x4*)(h + off0 + bj * HALF + n * 16); ps[m][bj][n] = *(const PG8_GAS u32x2*)(proj + off0 + bj * HALF + n * 16); } }
            asm volatile("" ::: "memory");
#pragma unroll
            for (int m = m0; m < m0 + 2; ++m) { const int row = row0 + ai * HALF + m * 16; const size_t off0 = (size_t)row * 1024 + col0; const float rs = rstd_of(sq[m]); float ss = 0.f;
#pragma unroll
                for (int bj = 0; bj < 2; ++bj)
#pragma unroll
                    for (int n = 0; n < 2; ++n) { const size_t off = off0 + bj * HALF + n * 16; const u32x2 pw = ps[m][bj][n]; const f32x4 a = acc[ai][bj][m][n] * rs;
                        f32x4 pr; pr[0] = __uint_as_float(pw.x << 16); pr[1] = __uint_as_float(pw.x & 0xffff0000u); pr[2] = __uint_as_float(pw.y << 16); pr[3] = __uint_as_float(pw.y & 0xffff0000u);
                        f32x4 v = hs[m][bj][n];
#pragma unroll
                        for (int i = 0; i < 4; ++i) v[i] += sigm(a[i]) * pr[i];
                        *(PG8_GAS f32x4*)(h + off) = v; u32x2 w; w.x = cvt_pk_bf16(v[0], v[1]); w.y = cvt_pk_bf16(v[2], v[3]); *(PG8_GAS u32x2*)(hb + off) = w;
                        ss += (v[0] * v[0] + v[1] * v[1]) + (v[2] * v[2] + v[3] * v[3]); }
                ss += __shfl_xor(ss, 16); ss += __shfl_xor(ss, 32);
                if (fq == 0) atomic_addf(ssq_next + row, ss); }
            asm volatile("" ::: "memory");
        }
    }
};
template <class Epi, class Sched, bool ALIGN_EPI = false, bool SP2 = false>
__device__ __forceinline__ void gemm_phase(PG8_LAS unsigned char* lds, const Gemm g, const Sched& S, const Epi& E) {
    int tid_ = threadIdx.x; asm volatile("" : "+v"(tid_));
    const int tid = tid_, wid = __builtin_amdgcn_readfirstlane(tid >> 6), lane = tid & 63, wr = wid >> 2, wc = wid & 3, fr = lane & 15, fq = lane >> 4;
    const int K = g.K, nt = K / BK;
    unsigned voffA[2], voffB[2];
#pragma unroll
    for (int i = 0; i < 2; ++i) { int R, C; stage_rc(tid * 16 + i * 8192, R, C); const int Rb = Epi::PERM ? ((R & ~31) + perm32(R & 31)) : R;
        voffA[i] = (unsigned)(R * K + C) * 2u; voffB[i] = (unsigned)(Rb * K + C) * 2u; }
    const size_t kstep = (size_t)(BK * 2);
    const size_t hstep = (size_t)HALF * K * 2;
    const size_t tstep = 2 * hstep;
    const unsigned ldsw = (unsigned)wid * 1024u;
    const int aoff = lds_byte(wr * 64 + fr, fq * 8), boff = lds_byte(wc * 32 + fr, fq * 8);
#define PG8_SA(b, h) (((b) * 2 + (h)) * HTB)
#define PG8_SB(b, h) ((4 + (b) * 2 + (h)) * HTB)
#define PG8_STAGE(bufoff, gbase, voff) do { _Pragma("unroll") for (int _i = 0; _i < 2; ++_i) \
        __builtin_amdgcn_global_load_lds((const unsigned*)((const char*)(gbase) + (voff)[_i]), (PG8_LAS unsigned*)(lds + (bufoff) + ldsw + _i * 8192), 16, 0, 0); } while (0)
#define PG8_LDA(dst, b, h) do { _Pragma("unroll") for (int m = 0; m < 4; ++m) _Pragma("unroll") for (int k = 0; k < 2; ++k) dst[m][k] = *(const PG8_LAS bf16x8*)(lds + PG8_SA(b, h) + aoff + m * 2048 + k * 1024); } while (0)
#define PG8_LDB(dst, b, h) do { _Pragma("unroll") for (int n = 0; n < 2; ++n) _Pragma("unroll") for (int k = 0; k < 2; ++k) dst[n][k] = *(const PG8_LAS bf16x8*)(lds + PG8_SB(b, h) + boff + n * 2048 + k * 1024); } while (0)
#define PG8_MMA(ai, bj, At, Bt) do { __builtin_amdgcn_s_setprio(1); _Pragma("unroll") for (int m = 0; m < 4; ++m) _Pragma("unroll") for (int n = 0; n < 2; ++n) _Pragma("unroll") for (int k = 0; k < 2; ++k) \
        acc[ai][bj][m][n] = __builtin_amdgcn_mfma_f32_16x16x32_bf16(Bt[n][k], At[m][k], acc[ai][bj][m][n], 0, 0, 0); __builtin_amdgcn_s_setprio(0); } while (0)
#define PG8_WAIT_V(n) asm volatile("s_waitcnt vmcnt(" #n ")" ::: "memory")
#define PG8_WAIT_L(n) asm volatile("s_waitcnt lgkmcnt(" #n ")" ::: "memory")
#define PG8_BAR __builtin_amdgcn_s_barrier()
#define PG8_SCHED __builtin_amdgcn_sched_barrier(0)
    Unit cur, nxt; int ui = 0;
    if (!S.next(0, cur)) return;
    f32x4 acc[2][2][4][2];
#pragma unroll
    for (int a = 0; a < 2; ++a)
#pragma unroll
        for (int b = 0; b < 2; ++b)
#pragma unroll
            for (int m = 0; m < 4; ++m)
#pragma unroll
                for (int n = 0; n < 2; ++n) acc[a][b][m][n] = (f32x4){0.f, 0.f, 0.f, 0.f};
    bf16x8 At[4][2], B0[2][2], B1[2][2];
    const char* cA = (const char*)g.A + (size_t)cur.pm * tstep; const char* cB = (const char*)g.Bt + (size_t)cur.pn * tstep;
    S.a_ready(cur);
    if constexpr (SP2) {
        PG8_STAGE(PG8_SB(0, 0), cB, voffB); PG8_STAGE(PG8_SB(0, 1), cB + hstep, voffB); PG8_STAGE(PG8_SA(0, 0), cA, voffA); PG8_STAGE(PG8_SA(0, 1), cA + hstep, voffA);
        if (wr == 1) PG8_BAR;
        PG8_WAIT_V(2); PG8_BAR;
        PG8_STAGE(PG8_SB(1, 0), cB + kstep, voffB); PG8_STAGE(PG8_SA(1, 0), cA + kstep, voffA); PG8_STAGE(PG8_SB(1, 1), cB + hstep + kstep, voffB);
        PG8_WAIT_V(6); PG8_BAR;
    } else {
        PG8_STAGE(PG8_SB(0, 0), cB, voffB); PG8_STAGE(PG8_SA(0, 0), cA, voffA); PG8_STAGE(PG8_SB(0, 1), cB + hstep, voffB); PG8_STAGE(PG8_SA(0, 1), cA + hstep, voffA);
        if (wr == 1) PG8_BAR;
        PG8_WAIT_V(4); PG8_BAR;
        PG8_STAGE(PG8_SB(1, 0), cB + kstep, voffB); PG8_STAGE(PG8_SA(1, 0), cA + kstep, voffA); PG8_STAGE(PG8_SB(1, 1), cB + hstep + kstep, voffB);
        PG8_WAIT_V(6); PG8_BAR;
    }
    for (;;) {
        const bool has_next = S.next(ui + 1, nxt);
        const char* nA = has_next ? (const char*)g.A + (size_t)nxt.pm * tstep : cA; const char* nB = has_next ? (const char*)g.Bt + (size_t)nxt.pn * tstep : cB;
        for (int t = 0; t < nt; t += 2) {
            const bool last = (t == nt - 2);
            const char* a1 = cA + (size_t)(t + 1) * kstep;
            const char* a2 = last ? nA : cA + (size_t)(t + 2) * kstep; const char* b2 = last ? nB : cB + (size_t)(t + 2) * kstep;
            const char* a3 = a2 + kstep; const char* b3 = b2 + kstep;
            if (last && has_next) S.a_ready(nxt);
            if constexpr (SP2) {
            PG8_LDB(B0, 0, 0); PG8_LDB(B1, 0, 1); PG8_SCHED; PG8_LDA(At, 0, 0); PG8_STAGE(PG8_SA(1, 1), a1 + hstep, voffA);
            PG8_WAIT_V(8); PG8_WAIT_L(0); PG8_BAR; PG8_MMA(0, 0, At, B0); PG8_MMA(0, 1, At, B1); PG8_BAR; PG8_SCHED;
            PG8_LDA(At, 0, 1); PG8_STAGE(PG8_SB(0, 0), b2, voffB); PG8_STAGE(PG8_SB(0, 1), b2 + hstep, voffB); PG8_STAGE(PG8_SA(0, 0), a2, voffA);
            PG8_WAIT_V(8); PG8_WAIT_L(0); PG8_BAR; PG8_MMA(1, 0, At, B0); PG8_MMA(1, 1, At, B1); PG8_BAR; PG8_SCHED;
            PG8_LDB(B0, 1, 0); PG8_LDB(B1, 1, 1); PG8_SCHED; PG8_LDA(At, 1, 0); PG8_STAGE(PG8_SA(0, 1), a2 + hstep, voffA);
            PG8_WAIT_V(8); PG8_WAIT_L(0); PG8_BAR; PG8_MMA(0, 0, At, B0); PG8_MMA(0, 1, At, B1); PG8_BAR; PG8_SCHED;
            PG8_LDA(At, 1, 1); PG8_STAGE(PG8_SB(1, 0), b3, voffB); PG8_STAGE(PG8_SB(1, 1), b3 + hstep, voffB); PG8_STAGE(PG8_SA(1, 0), a3, voffA);
            PG8_WAIT_V(8); PG8_WAIT_L(0); PG8_BAR; PG8_MMA(1, 0, At, B0); PG8_MMA(1, 1, At, B1); PG8_BAR; PG8_SCHED;
            } else {
            PG8_LDB(B0, 0, 0); PG8_SCHED; PG8_LDA(At, 0, 0); PG8_STAGE(PG8_SA(1, 1), a1 + hstep, voffA);
            PG8_WAIT_L(8); PG8_BAR; PG8_WAIT_L(0); PG8_MMA(0, 0, At, B0); PG8_BAR; PG8_SCHED;
            PG8_LDB(B1, 0, 1); PG8_STAGE(PG8_SB(0, 0), b2, voffB);
            PG8_BAR; PG8_WAIT_L(0); PG8_MMA(0, 1, At, B1); PG8_BAR;
            PG8_LDA(At, 0, 1); PG8_STAGE(PG8_SA(0, 0), a2, voffA);
            PG8_BAR; PG8_WAIT_L(0); PG8_MMA(1, 0, At, B0); PG8_BAR; PG8_SCHED;
            PG8_STAGE(PG8_SB(0, 1), b2 + hstep, voffB);
            PG8_WAIT_V(6); PG8_BAR; PG8_MMA(1, 1, At, B1); PG8_BAR;
            PG8_LDB(B0, 1, 0); PG8_SCHED; PG8_LDA(At, 1, 0); PG8_STAGE(PG8_SA(0, 1), a2 + hstep, voffA);
            PG8_WAIT_L(8); PG8_BAR; PG8_WAIT_L(0); PG8_MMA(0, 0, At, B0); PG8_BAR; PG8_SCHED;
            PG8_LDB(B1, 1, 1); PG8_STAGE(PG8_SB(1, 0), b3, voffB);
            PG8_BAR; PG8_WAIT_L(0); PG8_MMA(0, 1, At, B1); PG8_BAR;
            PG8_LDA(At, 1, 1); PG8_STAGE(PG8_SA(1, 0), a3, voffA);
            PG8_BAR; PG8_WAIT_L(0); PG8_MMA(1, 0, At, B0); PG8_BAR; PG8_SCHED;
            PG8_STAGE(PG8_SB(1, 1), b3 + hstep, voffB);
            PG8_WAIT_V(6); PG8_BAR; PG8_MMA(1, 1, At, B1); PG8_BAR;
            }
        }
        if constexpr (ALIGN_EPI) { if (wr == 0) PG8_BAR; }
        if constexpr (!Epi::AFTER_DRAIN) { E(acc, cur, wr, wc, fr, fq); S.done(cur); }
        if (!has_next) break;
#pragma unroll
        for (int a = 0; a < 2; ++a)
#pragma unroll
            for (int b = 0; b < 2; ++b)
#pragma unroll
                for (int m = 0; m < 4; ++m)
#pragma unroll
                    for (int n = 0; n < 2; ++n) acc[a][b][m][n] = (f32x4){0.f, 0.f, 0.f, 0.f};
        cur = nxt; cA = nA; cB = nB; ++ui;
        if constexpr (ALIGN_EPI) { if (wr == 1) PG8_BAR; }
    }
    PG8_WAIT_V(0);
    if constexpr (!ALIGN_EPI) { if (wr == 0) PG8_BAR; }
    PG8_BAR;
    if constexpr (Epi::AFTER_DRAIN) { E.fused(acc, cur, wr, wc, fr, fq, lds, wid, lane); S.done(cur); }
#undef PG8_SA
#undef PG8_SB
#undef PG8_STAGE
#undef PG8_LDA
#undef PG8_LDB
#undef PG8_MMA
#undef PG8_WAIT_V
#undef PG8_WAIT_L
#undef PG8_BAR
#undef PG8_SCHED
}
}
namespace att {
#define LAS __attribute__((address_space(3)))
typedef unsigned short bf16_t;
typedef short bf16x8 __attribute__((ext_vector_type(8)));
typedef float f32x4 __attribute__((ext_vector_type(4)));
typedef float f32x16 __attribute__((ext_vector_type(16)));
typedef unsigned u32x4 __attribute__((ext_vector_type(4)));
typedef unsigned u32x2 __attribute__((ext_vector_type(2)));
typedef float f32x2_t __attribute__((ext_vector_type(2))); typedef __bf16 bf16x2_t __attribute__((ext_vector_type(2)));
constexpr float LOG2E = 1.4426950408889634f;
constexpr int SEQ = 4096, MTOK = 65536;
__device__ __forceinline__ unsigned cvtpk(float lo, float hi) { f32x2_t v = {lo, hi}; bf16x2_t b = __builtin_convertvector(v, bf16x2_t); return __builtin_bit_cast(unsigned, b); }

#define GAS __attribute__((address_space(1)))
__device__ __forceinline__ void da_knorm(const bf16_t* QK_, float* kn_, int gw, int NGW, int lane) {
    const GAS bf16_t* QK = (const GAS bf16_t*)QK_; GAS float* kn = (GAS float*)kn_;
    for (int task = gw; task < 16 * 8 * 64; task += NGW) {
        const int b = task >> 9, h = (task >> 6) & 7, t = task & 63;
        const GAS u32x4* p = (const GAS u32x4*)(QK + ((size_t)b * SEQ + t * 64 + lane) * 2048 + 1024 + h * 128);
        float a[2] = {0.f, 0.f};
#pragma unroll
        for (int c = 0; c < 16; ++c) { const u32x4 w = p[c];
#pragma unroll
            for (int i = 0; i < 4; ++i) { const float lo = __uint_as_float(w[i] << 16), hi = __uint_as_float(w[i] & 0xffff0000u); a[c >> 3] += lo * lo + hi * hi; } }
        float m = __builtin_fmaxf(a[0], a[1]);
#pragma unroll
        for (int o = 1; o < 64; o <<= 1) m = __builtin_fmaxf(m, __shfl_xor(m, o));
        if (lane == 0) kn[task] = __builtin_sqrtf(m) * 1.002f;
    }
}
__device__ __forceinline__ void da_phase(LAS unsigned char* lds, const bf16_t* QK_, const bf16_t* VT_, bf16_t* AO_, const float* kn_,
                                         float lam, float outscale, const float* subln_, int G, int bx) {
    int tid_ = threadIdx.x; asm volatile("" : "+v"(tid_));
    const int tid = tid_, lane = tid & 63, wid = __builtin_amdgcn_readfirstlane(tid >> 6), q = lane & 31, hi = lane >> 5, mp = wid >> 2, wq = wid & 3;
    const GAS bf16_t* QK = (const GAS bf16_t*)QK_; const GAS bf16_t* VT = (const GAS bf16_t*)VT_; GAS bf16_t* AO = (GAS bf16_t*)AO_; const GAS float* kn = (const GAS float*)kn_; const GAS float* subln = (const GAS float*)subln_;
    const int pi = (q & ~12) | ((q & 8) >> 1) | ((q & 4) << 1);
    unsigned rk[4], rv[4];
#pragma unroll
    for (int s = 0; s < 4; ++s) { const int ck = 2 * s + hi; rk[s] = mp * 8192 + ck * 1024 + (pi ^ ck) * 16; }
#pragma unroll
    for (int jv = 0; jv < 4; ++jv) { const int cv = 2 * jv + hi; rv[jv] = 16384 + cv * 2048 + (q ^ cv) * 16; }
    const int kr = tid >> 4, kch = tid & 15, vd = tid >> 3, vc = tid & 7;
    const unsigned kdst = (kch >> 3) * 8192 + (kch & 7) * 1024 + (kr ^ (kch & 7)) * 16, vdst = 16384 + vc * 2048 + (vd ^ vc) * 16;
    LAS float* xch = (LAS float*)(lds + 65536) + wq * 4096 + lane;
    LAS float* red = (LAS float*)(lds + 131072);
    for (int un = bx; un < 4096; un += G) {
        int b, h, qb; if (G == 256) { const int k = un >> 8; b = k; h = (bx + k) & 7; qb = ((bx >> 3) + 16 * (k & 1)) & 31; } else { b = un >> 8; h = (un >> 5) & 7; qb = un & 31; }
        const float nslope2 = -__builtin_amdgcn_exp2f(-(float)(h + 1)) * LOG2E;
        const size_t tokb = (size_t)b * SEQ;
        const int qpos = qb * 128 + wq * 32 + q;
        const GAS bf16_t* ksrc = QK + (tokb + kr) * 2048 + 1024 + h * 128 + kch * 8;
        const GAS bf16_t* vsrc = VT + (size_t)(h * 128 + vd) * MTOK + tokb + vc * 8;
        u32x4 sa0, sa1, sa2, sa3, sb0, sb1, sb2, sb3;
#define DA_LOADT(S, t) do { S##0 = *(const GAS u32x4*)(ksrc + (size_t)(t) * 64 * 2048); S##1 = *(const GAS u32x4*)(ksrc + (size_t)(t) * 64 * 2048 + 32 * 2048); \
                         S##2 = *(const GAS u32x4*)(vsrc + (t) * 64); S##3 = *(const GAS u32x4*)(vsrc + (size_t)64 * MTOK + (t) * 64); } while (0)
#define DA_STORET(S, bo) do { *(LAS u32x4*)(lds + (bo) + kdst) = S##0; *(LAS u32x4*)(lds + (bo) + kdst + 512) = S##1; *(LAS u32x4*)(lds + (bo) + vdst) = S##2; *(LAS u32x4*)(lds + (bo) + vdst + 1024) = S##3; } while (0)
        const int d0 = 2 * qb, d1 = 2 * qb + 1;
        DA_LOADT(sa, d0); DA_LOADT(sb, d1);
        bf16x8 qf[4]; float qn2 = 0.f;
        { const GAS bf16_t* qp = QK + (tokb + qpos) * 2048 + h * 128 + mp * 64 + 8 * hi;
#pragma unroll
          for (int s = 0; s < 4; ++s) { qf[s] = *(const GAS bf16x8*)(qp + 16 * s);
#pragma unroll
              for (int i = 0; i < 8; ++i) { const float v = __uint_as_float(((unsigned)(unsigned short)qf[s][i]) << 16); qn2 += v * v; } } }
        qn2 += __shfl_xor(qn2, 32);
        const float knl = kn[(b * 8 + h) * 64 + lane];
        f32x16 o[4];
#pragma unroll
        for (int d = 0; d < 4; ++d) o[d] = f32x16{};
        float mref = 0.f, l = 0.f;
#define DA_COMPUTE(t, bo, FIRST, LIN) do { \
            f32x16 p[2]; \
            const float dbase = (float)((t) * 64 + 8 * hi - qpos); \
            const float sg_ = ((t) < d0) ? -nslope2 : nslope2, A_ = dbase * sg_ - mref;     \
            _Pragma("unroll") for (int hf = 0; hf < 2; ++hf) { \
                if (LIN) { _Pragma("unroll") for (int r = 0; r < 16; ++r) p[hf][r] = __builtin_fmaf((float)(32 * hf + 16 * (r >> 3) + (r & 7)), sg_, A_); } \
                else { _Pragma("unroll") for (int r = 0; r < 16; ++r) p[hf][r] = __builtin_fmaf(__builtin_fabsf(dbase + (float)(32 * hf + 16 * (r >> 3) + (r & 7))), nslope2, -mref); } } \
              \
            _Pragma("unroll") for (int s = 0; s < 4; ++s) _Pragma("unroll") for (int hf = 0; hf < 2; ++hf) { \
                const bf16x8 kf = *(const LAS bf16x8*)(lds + (bo) + rk[s] + hf * 512); p[hf] = __builtin_amdgcn_mfma_f32_32x32x16_bf16(kf, qf[s], p[hf], 0, 0, 0); } \
            float mx = p[0][0]; \
            _Pragma("unroll") for (int r = 1; r < 16; ++r) mx = __builtin_fmaxf(mx, p[0][r]); \
            _Pragma("unroll") for (int r = 0; r < 16; ++r) mx = __builtin_fmaxf(mx, p[1][r]); \
            mx = __builtin_fmaxf(mx, __shfl_xor(mx, 32)); \
              \
            if (!(FIRST) && !__any(mx > -36.0f)) break; \
            if (FIRST) { mref = mx; \
                _Pragma("unroll") for (int r = 0; r < 16; ++r) { p[0][r] -= mx; p[1][r] -= mx; } } \
            else if (__any(mx > 8.0f)) { const float dl = __builtin_fmaxf(mx, 0.f); mref += dl; const float f = __builtin_amdgcn_exp2f(-dl); l *= f; \
                _Pragma("unroll") for (int r = 0; r < 16; ++r) { p[0][r] -= dl; p[1][r] -= dl; } \
                _Pragma("unroll") for (int d = 0; d < 4; ++d) _Pragma("unroll") for (int r = 0; r < 16; ++r) o[d][r] *= f; } \
            float sacc = 0.f; \
            _Pragma("unroll") for (int hf = 0; hf < 2; ++hf) _Pragma("unroll") for (int r = 0; r < 16; ++r) { p[hf][r] = __builtin_amdgcn_exp2f(p[hf][r]); sacc += p[hf][r]; } \
            l += sacc; \
            bf16x8 pf[2][2]; \
            _Pragma("unroll") for (int hf = 0; hf < 2; ++hf) _Pragma("unroll") for (int u = 0; u < 2; ++u) { u32x4 w; w.x = cvtpk(p[hf][8 * u], p[hf][8 * u + 1]); w.y = cvtpk(p[hf][8 * u + 2], p[hf][8 * u + 3]); \
                    w.z = cvtpk(p[hf][8 * u + 4], p[hf][8 * u + 5]); w.w = cvtpk(p[hf][8 * u + 6], p[hf][8 * u + 7]); pf[hf][u] = __builtin_bit_cast(bf16x8, w); } \
            _Pragma("unroll") for (int hf = 0; hf < 2; ++hf) _Pragma("unroll") for (int u = 0; u < 2; ++u) _Pragma("unroll") for (int d = 0; d < 4; ++d) { \
                    const bf16x8 vf = *(const LAS bf16x8*)(lds + (bo) + rv[2 * hf + u] + d * 512); o[d] = __builtin_amdgcn_mfma_f32_32x32x16_bf16(vf, pf[hf][u], o[d], 0, 0, 0); } \
        } while (0)
        DA_STORET(sa, 0);
        __syncthreads();
        DA_COMPUTE(d0, 0, true, false);
        DA_STORET(sb, 32768);
        __syncthreads();
        DA_COMPUTE(d1, 32768, false, false);
        { float lmin = mref, qmx = qn2;
#pragma unroll
          for (int o_ = 1; o_ < 64; o_ <<= 1) { lmin = __builtin_fminf(lmin, __shfl_xor(lmin, o_)); qmx = __builtin_fmaxf(qmx, __shfl_xor(qmx, o_)); }
          if (lane == 0) { red[2 * wid] = lmin; red[2 * wid + 1] = qmx; } }
        __syncthreads();
        unsigned long long mask;
        { float Lmin = red[0], Q2 = red[1];
#pragma unroll
          for (int w = 1; w < 8; ++w) { Lmin = __builtin_fminf(Lmin, red[2 * w]); Q2 = __builtin_fmaxf(Q2, red[2 * w + 1]); }
          const float Qmax = __builtin_sqrtf(Q2) * 1.002f;
          const int t = lane, mind = (t < d0) ? (qb * 128 - (t * 64 + 63)) : (t * 64 - (qb * 128 + 127));
          const float bound = Qmax * knl + nslope2 * (float)mind;
          const bool need = (t != d0) && (t != d1) && (bound >= Lmin - 36.0f);
          mask = __ballot(need); }
        if (mask) {
#define DA_POP(v) do { v = -1; if (mask) { v = (int)__builtin_ctzll(mask); mask &= mask - 1; } } while (0)
            int cur, n1, n2; DA_POP(cur); DA_POP(n1);
            unsigned bo = 0;
            DA_LOADT(sa, cur); DA_LOADT(sb, (n1 >= 0 ? n1 : cur));
            DA_STORET(sa, 0);
            __syncthreads();
#define DA_STEP(X, Y) { DA_POP(n2); DA_LOADT(Y, (n2 >= 0 ? n2 : cur)); DA_COMPUTE(cur, bo, false, true); if (n1 < 0) break; DA_STORET(X, bo ^ 32768); __syncthreads(); bo ^= 32768; cur = n1; n1 = n2; }
            for (;;) { DA_STEP(sb, sa) DA_STEP(sa, sb) }
#undef DA_STEP
#undef DA_POP
        }
        __syncthreads();
#undef DA_LOADT
#undef DA_STORET
#undef DA_COMPUTE
        l += __shfl_xor(l, 32);
        const float inv = 1.0f / l;
        if (mp == 1) {
#pragma unroll
            for (int d = 0; d < 4; ++d)
#pragma unroll
                for (int r = 0; r < 16; ++r) xch[(d * 16 + r) * 64] = o[d][r] * inv;
        }
        __syncthreads();
        if (mp == 0) {
            float ss = 0.f;
#pragma unroll
            for (int d = 0; d < 4; ++d)
#pragma unroll
                for (int r = 0; r < 16; ++r) { const float v = o[d][r] * inv - lam * xch[(d * 16 + r) * 64]; o[d][r] = v; ss += v * v; }
            ss += __shfl_xor(ss, 32);
            const float rs = rsqrtf(ss * (1.0f / 128.0f) + 1e-5f) * outscale;
            GAS bf16_t* op = AO + (tokb + qpos) * 1024 + h * 128 + 4 * hi;
#pragma unroll
            for (int d = 0; d < 4; ++d)
#pragma unroll
                for (int r4 = 0; r4 < 4; ++r4) { const f32x4 g = *(const GAS f32x4*)(subln + 32 * d + 8 * r4 + 4 * hi);
                    u32x2 w; w.x = cvtpk(o[d][4 * r4] * rs * g[0], o[d][4 * r4 + 1] * rs * g[1]); w.y = cvtpk(o[d][4 * r4 + 2] * rs * g[2], o[d][4 * r4 + 3] * rs * g[3]);
                    *(GAS u32x2*)(op + 32 * d + 8 * r4) = w; }
        }
    }
}
#undef GAS

#define GAS __attribute__((address_space(1)))
constexpr int NA_RING = 147456, NA_TB = NA_RING;
__device__ __forceinline__ void na_phase(LAS unsigned char* lds, const bf16_t* QK_, const bf16_t* VT_, bf16_t* AO_, const float* rpb_, int G, int bx) {
    int tid_ = threadIdx.x; asm volatile("" : "+v"(tid_));
    const int tid = tid_, lane = tid & 63, wid = __builtin_amdgcn_readfirstlane(tid >> 6), n = lane & 15, g = lane >> 4;
    const GAS bf16_t* QK = (const GAS bf16_t*)QK_; const GAS bf16_t* VT = (const GAS bf16_t*)VT_; GAS bf16_t* AO = (GAS bf16_t*)AO_; const GAS float* rpb = (const GAS float*)rpb_;
    LAS float* tb = (LAS float*)(lds + NA_TB);
    const int rq = wid >> 2, qg = wid & 3, c0 = 16 * qg, cw0 = (qg == 0) ? 0 : (qg == 1) ? 8 : (qg == 2) ? 24 : 32;
    const int c = c0 + n, cs = min(max(c - 8, 0), 48);
    unsigned ka[2], va[2];
#pragma unroll
    for (int ks = 0; ks < 2; ++ks) ka[ks] = (cw0 + n) * 128 + (((4 * ks + g) ^ (n & 7)) * 16);
    { const int c8 = (cw0 >> 2) + g; va[0] = 8192 + n * 128 + (((c8 >> 1) ^ (n & 7)) * 16) + (c8 & 1) * 8; va[1] = 8192 + n * 128 + ((((c8 >> 1) + 2) ^ (n & 7)) * 16) + (c8 & 1) * 8; }
    const int tr = tid >> 3, tc = tid & 7;
    const unsigned sdst = tr * 128 + ((tc ^ (tr & 7)) * 16);
    int bidx[8]; unsigned vmask = 0;
#pragma unroll
    for (int j8 = 0; j8 < 8; ++j8) { const int kc = cw0 + 16 * (j8 >> 2) + 4 * g + (j8 & 3); bidx[j8] = min(max(kc - c + 15, 0), 30); vmask |= ((unsigned)(kc - cs) < 16u) ? (1u << j8) : 0u; }
    for (int un = bx; un < 256; un += G) {
        const int b = un >> 4, h = un & 15;
        __syncthreads();
        for (int i = tid; i < 15 * 31; i += 512) tb[i] = rpb[h * 465 + i] * LOG2E;
        const GAS bf16_t* ksrc = QK + ((size_t)b * SEQ + tr) * 2048 + 1024 + h * 64 + tc * 8;
        const GAS bf16_t* vsrc = VT + (size_t)(h * 64 + tr) * MTOK + (size_t)b * SEQ + tc * 8;
#define NA_LDK(row) (*(const GAS u32x4*)(ksrc + (size_t)(row) * 64 * 2048))
#define NA_LDV(row) (*(const GAS u32x4*)(vsrc + (row) * 64))
#define NA_ST(row, kv, vv_) do { const unsigned so_ = (unsigned)((row) % 9) * 16384u + sdst; *(LAS u32x4*)(lds + so_) = (kv); *(LAS u32x4*)(lds + so_ + 8192) = (vv_); } while (0)
#pragma unroll
        for (int row = 0; row < 8; row += 4) { const u32x4 a0 = NA_LDK(row), b0 = NA_LDV(row), a1 = NA_LDK(row + 1), b1 = NA_LDV(row + 1), a2 = NA_LDK(row + 2), b2 = NA_LDV(row + 2), a3 = NA_LDK(row + 3), b3 = NA_LDV(row + 3);
            NA_ST(row, a0, b0); NA_ST(row + 1, a1, b1); NA_ST(row + 2, a2, b2); NA_ST(row + 3, a3, b3); }
        int loaded_hi = 7;
        const GAS bf16_t* qbase = QK + ((size_t)b * SEQ + rq * 64 + c0 + n) * 2048 + h * 64 + 8 * g;
        bf16x8 q0 = *(const GAS bf16x8*)qbase, q1 = *(const GAS bf16x8*)(qbase + 32);
        __syncthreads();
        for (int s = 0; s < 32; ++s) {
            const int tgt = (s < 31) ? (min(max(2 * s - 1, 0), 56) + 7) : loaded_hi;
            const int nnew = tgt - loaded_hi;
            const int ra_ = min(loaded_hi + 1, 63), rb_ = min(loaded_hi + 2, 63);
            const u32x4 p0 = NA_LDK(ra_), p1 = NA_LDV(ra_), p2 = NA_LDK(rb_), p3 = NA_LDV(rb_);
            const int sn = (s < 31) ? s + 1 : s;
            const bf16x8 q0n = *(const GAS bf16x8*)(qbase + (size_t)sn * 128 * 2048), q1n = *(const GAS bf16x8*)(qbase + (size_t)sn * 128 * 2048 + 32);
            const int r = 2 * s + rq, rs = min(max(r - 4, 0), 56);
            const int slot0 = rs % 9;
            float bvl[8][8];
#pragma unroll
            for (int kr = 0; kr < 8; ++kr) { const LAS float* rowp = tb + (rs + kr - r + 7) * 31;
#pragma unroll
                for (int j8 = 0; j8 < 8; ++j8) bvl[kr][j8] = rowp[bidx[j8]]; }
            __builtin_amdgcn_sched_group_barrier(0x100, 64, 0);
            f32x4 st[16];
#pragma unroll
            for (int kp = 0; kp < 4; ++kp) {
                bf16x8 kf[2][2][2];
#pragma unroll
                for (int k2 = 0; k2 < 2; ++k2) { int sl = slot0 + 2 * kp + k2; sl = (sl >= 9) ? sl - 9 : sl; const unsigned base = (unsigned)sl * 16384u;
#pragma unroll
                    for (int hf = 0; hf < 2; ++hf) { kf[k2][hf][0] = *(const LAS bf16x8*)(lds + base + hf * 2048 + ka[0]); kf[k2][hf][1] = *(const LAS bf16x8*)(lds + base + hf * 2048 + ka[1]); } }
#pragma unroll
                for (int k2 = 0; k2 < 2; ++k2)
#pragma unroll
                    for (int hf = 0; hf < 2; ++hf) { f32x4 a = __builtin_amdgcn_mfma_f32_16x16x32_bf16(kf[k2][hf][0], q0, (f32x4){0.f, 0.f, 0.f, 0.f}, 0, 0, 0);
                        st[(2 * kp + k2) * 2 + hf] = __builtin_amdgcn_mfma_f32_16x16x32_bf16(kf[k2][hf][1], q1, a, 0, 0, 0); }
                __builtin_amdgcn_sched_group_barrier(0x100, 8, 0); __builtin_amdgcn_sched_group_barrier(0x008, 8, 0);
            }
            float mx = -INFINITY;
#pragma unroll
            for (int kr = 0; kr < 8; ++kr)
#pragma unroll
                for (int j8 = 0; j8 < 8; ++j8) { const float v = ((vmask >> j8) & 1u) ? st[kr * 2 + (j8 >> 2)][j8 & 3] + bvl[kr][j8] : -INFINITY; st[kr * 2 + (j8 >> 2)][j8 & 3] = v; mx = __builtin_fmaxf(mx, v); }
            mx = __builtin_fmaxf(mx, __shfl_xor(mx, 16)); mx = __builtin_fmaxf(mx, __shfl_xor(mx, 32));
            float l = 0.f;
#pragma unroll
            for (int ti = 0; ti < 16; ++ti)
#pragma unroll
                for (int i = 0; i < 4; ++i) { const float e = __builtin_amdgcn_exp2f(st[ti][i] - mx); st[ti][i] = e; l += e; }
            l += __shfl_xor(l, 16); l += __shfl_xor(l, 32);
            const float inv = 1.0f / l;
            f32x4 o[4];
#pragma unroll
            for (int dt = 0; dt < 4; ++dt) o[dt] = (f32x4){0.f, 0.f, 0.f, 0.f};
#pragma unroll
            for (int kp = 0; kp < 4; ++kp) {
                u32x2 vv[2][4][2];
#pragma unroll
                for (int k2 = 0; k2 < 2; ++k2) { int sl = slot0 + 2 * kp + k2; sl = (sl >= 9) ? sl - 9 : sl; const unsigned base = (unsigned)sl * 16384u;
#pragma unroll
                    for (int dt = 0; dt < 4; ++dt) { vv[k2][dt][0] = *(const LAS u32x2*)(lds + base + dt * 2048 + va[0]); vv[k2][dt][1] = *(const LAS u32x2*)(lds + base + dt * 2048 + va[1]); } }
#pragma unroll
                for (int k2 = 0; k2 < 2; ++k2) { const int kr = 2 * kp + k2;
                    u32x4 w; w.x = cvtpk(st[2 * kr][0], st[2 * kr][1]); w.y = cvtpk(st[2 * kr][2], st[2 * kr][3]); w.z = cvtpk(st[2 * kr + 1][0], st[2 * kr + 1][1]); w.w = cvtpk(st[2 * kr + 1][2], st[2 * kr + 1][3]);
                    const bf16x8 pf = __builtin_bit_cast(bf16x8, w);
#pragma unroll
                    for (int dt = 0; dt < 4; ++dt) { const u32x4 v4 = {vv[k2][dt][0].x, vv[k2][dt][0].y, vv[k2][dt][1].x, vv[k2][dt][1].y};
                        o[dt] = __builtin_amdgcn_mfma_f32_16x16x32_bf16(__builtin_bit_cast(bf16x8, v4), pf, o[dt], 0, 0, 0); } }
                __builtin_amdgcn_sched_group_barrier(0x100, 16, 0); __builtin_amdgcn_sched_group_barrier(0x008, 8, 0);
            }
            GAS bf16_t* op = AO + ((size_t)b * SEQ + r * 64 + c0 + n) * 1024 + h * 64 + 4 * g;
#pragma unroll
            for (int dt = 0; dt < 4; ++dt) { u32x2 w; w.x = cvtpk(o[dt][0] * inv, o[dt][1] * inv); w.y = cvtpk(o[dt][2] * inv, o[dt][3] * inv); *(GAS u32x2*)(op + 16 * dt) = w; }
            __syncthreads();
            if (nnew >= 1) NA_ST(loaded_hi + 1, p0, p1);
            if (nnew >= 2) NA_ST(loaded_hi + 2, p2, p3);
            loaded_hi = tgt; q0 = q0n; q1 = q1n;
            __syncthreads();
        }
#undef NA_LDK
#undef NA_LDV
#undef NA_ST
    }
}
#undef GAS
#undef LAS
}
#define LAS __attribute__((address_space(3)))
typedef unsigned short bf16;
typedef unsigned v4u __attribute__((ext_vector_type(4)));
typedef unsigned v2u __attribute__((ext_vector_type(2)));
typedef float f32x4 __attribute__((ext_vector_type(4)));
constexpr int NWAVES = 8, NTHR = 512;
constexpr int M = 65536, D = 1024, FF = 2816, PLE = 256, DEPTH = 4, SEQ = 4096;
constexpr size_t MiB = 1u << 20;
constexpr size_t WS_SSQ = 913 * MiB;
constexpr size_t WS_W = 4 * MiB, W_LAYER = 27 * MiB;
constexpr size_t WO_QKV = 0, WO_O = 6 * MiB, WO_GU = 8 * MiB, WO_DN = 19 * MiB, WO_PG = 19 * MiB + 5632 * 1024, WO_PP = WO_PG + 2 * MiB;
constexpr size_t WS_PB = 112 * MiB;
constexpr size_t WS_HB0 = 144 * MiB, WS_HB1 = 272 * MiB;
constexpr size_t WS_QK = 400 * MiB, WS_VT = 656 * MiB;
constexpr size_t WS_HID = 400 * MiB;
constexpr size_t WS_AO = 784 * MiB;
constexpr size_t WS_BAR = 912 * MiB;
constexpr size_t WS_KN = 920 * MiB;
constexpr size_t WS_END = 921 * MiB;
static_assert(WO_PP + (size_t)1024 * 256 * 2 <= W_LAYER && WS_W + 4 * W_LAYER <= WS_PB && WS_HID + (size_t)M * FF * 2 <= WS_AO, "ws map");
constexpr int LDS_BYTES = 155648;

struct Params {
    const float* in[22];
    float* out; unsigned char* ws;
};

__device__ __forceinline__ unsigned f2bf(float f) { unsigned u = __builtin_bit_cast(unsigned, f); return (u + 0x7fffu + ((u >> 16) & 1u)) >> 16; }
__device__ __forceinline__ unsigned pk2(float lo, float hi) { return f2bf(lo) | (f2bf(hi) << 16); }
__device__ __forceinline__ float wave_sum(float v) {
#pragma unroll
    for (int o = 1; o < 64; o <<= 1) v += __shfl_xor(v, o);
    return v;
}
__device__ __forceinline__ void transpose_item(const float* __restrict__ W, int K, int N, const float* __restrict__ gk, bf16* __restrict__ WT, int grp, int gstride, int goff, LAS float* scr, int item, int lane) {
    const int nblk = N / 32, kb = item / nblk, nb = item % nblk, k0 = 64 * kb, n0 = 32 * nb;
    float wv_[32], gs_[32];
#pragma unroll
    for (int i = 0; i < 32; ++i) { const int kk = 2 * i + (lane >> 5); gs_[i] = gk ? ((const __attribute__((address_space(1))) float*)gk)[k0 + kk] : 1.f; wv_[i] = ((const __attribute__((address_space(1))) float*)W)[(size_t)(k0 + kk) * N + n0 + (lane & 31)]; }
#pragma unroll
    for (int i = 0; i < 32; ++i) { const int kk = 2 * i + (lane >> 5); scr[kk * 33 + (lane & 31)] = wv_[i] * gs_[i]; }
    asm volatile("s_waitcnt lgkmcnt(0)" ::: "memory");
    const int c = lane & 7;
#pragma unroll
    for (int j = 0; j < 4; ++j) { const int n = (lane >> 3) + 8 * j; const LAS float* s = scr + (8 * c) * 33 + n;
        v4u o; o.x = pk2(s[0 * 33], s[1 * 33]); o.y = pk2(s[2 * 33], s[3 * 33]); o.z = pk2(s[4 * 33], s[5 * 33]); o.w = pk2(s[6 * 33], s[7 * 33]);
        const int nn = n0 + n, orow = (nn / grp) * gstride + goff + (nn % grp);
        *(__attribute__((address_space(1))) v4u*)(WT + (size_t)orow * K + k0 + 8 * c) = o; }
    asm volatile("s_waitcnt lgkmcnt(0)" ::: "memory");
}

__global__ void __launch_bounds__(NTHR) fwd_megakernel(Params P) {
    extern __shared__ __attribute__((aligned(16))) unsigned char lds_raw[];
    cg::grid_group grid = cg::this_grid();
    unsigned bar_gen = 0;
#define GRID_SYNC() do { asm volatile("s_waitcnt vmcnt(0) lgkmcnt(0)" ::: "memory"); __syncthreads(); \
        if (threadIdx.x == 0) { __builtin_amdgcn_fence(__ATOMIC_RELEASE, "agent"); asm volatile("s_waitcnt vmcnt(0)" ::: "memory"); bar_gen += 1u; \
              \
            const unsigned ngrp_ = (gridDim.x & 7u) ? 1u : 8u, gsz_ = gridDim.x / ngrp_; \
            unsigned* top_ = (unsigned*)(P.ws + WS_BAR); unsigned* grp_ = top_ + 64u * (1u + (ngrp_ == 8u ? (blockIdx.x & 7u) : 0u)); \
            const unsigned old_ = __hip_atomic_fetch_add(grp_, 1u, __ATOMIC_RELAXED, __HIP_MEMORY_SCOPE_AGENT); \
            if (old_ + 1u == gsz_ * bar_gen) __hip_atomic_fetch_add(top_, 1u, __ATOMIC_RELAXED, __HIP_MEMORY_SCOPE_AGENT); \
            while (__hip_atomic_load(top_, __ATOMIC_RELAXED, __HIP_MEMORY_SCOPE_AGENT) < ngrp_ * bar_gen) __builtin_amdgcn_s_sleep(1); \
            __builtin_amdgcn_fence(__ATOMIC_ACQUIRE, "agent"); asm volatile("s_waitcnt vmcnt(0)" ::: "memory"); } \
        __syncthreads(); } while (0)
    LAS unsigned char* lds = (LAS unsigned char*)lds_raw;
#define OPQ_TID() int tid = threadIdx.x; asm volatile("" : "+v"(tid)); const int lane = tid & 63, wave = __builtin_amdgcn_readfirstlane(tid >> 6); \
        const int G = gridDim.x, bx = blockIdx.x, gw = bx * NWAVES + wave, NGW = G * NWAVES; (void)lane; (void)gw; (void)NGW; (void)G; (void)bx
#define OPQ_WS() unsigned char* ws = P.ws; asm volatile("" : "+s"(ws)); pg8::u64* ssq = (pg8::u64*)(ws + WS_SSQ); float* out = P.out; asm volatile("" : "+s"(out))
#define OPQ_LAYER() OPQ_WS(); int lo = li; asm volatile("" : "+s"(lo)); const int j = lo >> 1; unsigned char* wl = ws + WS_W + (size_t)lo * W_LAYER; \
        bf16* HBc = (bf16*)(ws + ((lo & 1) ? WS_HB1 : WS_HB0)); bf16* HBn = (bf16*)(ws + ((lo & 1) ? WS_HB0 : WS_HB1)); \
        pg8::u64* ssq_mix = ssq + (size_t)(3 * lo) * M; pg8::u64* ssq_ffn = ssq_mix + M; pg8::u64* ssq_ple = ssq_ffn + M; pg8::u64* ssq_nxt = ssq_ple + M; \
        bf16* QK = (bf16*)(ws + WS_QK); bf16* VT = (bf16*)(ws + WS_VT); bf16* HID = (bf16*)(ws + WS_HID); bf16* AO = (bf16*)(ws + WS_AO); bf16* PB = (bf16*)(ws + WS_PB); \
        (void)j; (void)wl; (void)HBc; (void)HBn; (void)ssq_mix; (void)ssq_ffn; (void)ssq_ple; (void)ssq_nxt; (void)QK; (void)VT; (void)HID; (void)AO; (void)PB
    {
        OPQ_TID(); OPQ_WS(); (void)out; bf16* HB0 = (bf16*)(ws + WS_HB0);
        const float* x = P.in[0]; const float* norm_mix = P.in[2]; const float* norm_ffn = P.in[3]; const float* norm_ple = P.in[4];
        LAS float* scr = (LAS float*)(lds + wave * 16384);
        constexpr int I_QKV = 16 * 96, I_O = 16 * 32, I_G = 16 * 88, I_DN = 44 * 32, I_PG = 16 * 32, I_PP = 4 * 32, I_LAYER = I_QKV + I_O + 2 * I_G + I_DN + I_PG + I_PP;
        for (int it = gw; it < DEPTH * I_LAYER; it += NGW) {
            const int li = it / I_LAYER, j = li >> 1; int r = it % I_LAYER;
            unsigned char* wl = ws + WS_W + (size_t)li * W_LAYER;
            if (r < I_QKV) { const float* W = (li & 1) ? P.in[13] + (size_t)j * D * 3 * D : P.in[6] + (size_t)j * D * 3 * D;
                transpose_item(W, D, 3 * D, norm_mix + li * D, (bf16*)(wl + WO_QKV), 3 * D, 0, 0, scr, r, lane); continue; } r -= I_QKV;
            if (r < I_O) { const float* W = (li & 1) ? P.in[16] + (size_t)j * D * D : P.in[7] + (size_t)j * D * D;
                transpose_item(W, D, D, nullptr, (bf16*)(wl + WO_O), D, 0, 0, scr, r, lane); continue; } r -= I_O;
            if (r < I_G) { transpose_item(P.in[17] + (size_t)li * D * FF, D, FF, norm_ffn + li * D, (bf16*)(wl + WO_GU), 128, 256, 0, scr, r, lane); continue; } r -= I_G;
            if (r < I_G) { transpose_item(P.in[18] + (size_t)li * D * FF, D, FF, norm_ffn + li * D, (bf16*)(wl + WO_GU), 128, 256, 128, scr, r, lane); continue; } r -= I_G;
            if (r < I_DN) { transpose_item(P.in[19] + (size_t)li * FF * D, FF, D, nullptr, (bf16*)(wl + WO_DN), D, 0, 0, scr, r, lane); continue; } r -= I_DN;
            if (r < I_PG) { transpose_item(P.in[21] + (size_t)li * D * D, D, D, norm_ple + li * D, (bf16*)(wl + WO_PG), D, 0, 0, scr, r, lane); continue; } r -= I_PG;
            transpose_item(P.in[20] + (size_t)li * PLE * D, PLE, D, nullptr, (bf16*)(wl + WO_PP), D, 0, 0, scr, r, lane);
        }
        for (int g32 = gw; g32 < M / 32; g32 += NGW) {
            float keep = 0.f;
#pragma unroll 4
            for (int rr = 0; rr < 32; ++rr) {
                const int m = g32 * 32 + rr;
                const f32x4* xr = (const f32x4*)(x + (size_t)m * D) + lane; f32x4 v[4]; float sq = 0.f;
#pragma unroll
                for (int jj = 0; jj < 4; ++jj) { v[jj] = xr[64 * jj]; sq += (v[jj].x * v[jj].x + v[jj].y * v[jj].y) + (v[jj].z * v[jj].z + v[jj].w * v[jj].w); }
                sq = wave_sum(sq); if (lane == rr) keep = sq;
                v2u* o8 = (v2u*)(HB0 + (size_t)m * D) + lane;
#pragma unroll
                for (int jj = 0; jj < 4; ++jj) { v2u w; w.x = pk2(v[jj].x, v[jj].y); w.y = pk2(v[jj].z, v[jj].w); o8[64 * jj] = w; }
            }
            if (lane < 32) ssq[g32 * 32 + lane] = (pg8::u64)(keep * pg8::SSQ_FIX + 0.5f);
        }
        for (int i = bx * NTHR + tid; i < 12 * M / 2; i += G * NTHR) ((v4u*)(ssq + M))[i] = (v4u){0u, 0u, 0u, 0u};
    }
    GRID_SYNC();
    grid.sync();

#pragma unroll 1
    for (int li = 0; li < DEPTH; ++li) {
        const bool is_da = (li & 1) == 0;
        {
            OPQ_TID(); OPQ_LAYER();
            const float* bqkv = is_da ? nullptr : P.in[14] + (size_t)j * 3 * D;
            { pg8::Gemm g{HBc, (const bf16*)(wl + WO_QKV), M, 2 * D, D}; pg8::StaticOrder S; S.init(M, 2 * D, G, bx);
              pg8::EpiQK E{QK, 2 * D, ssq_mix, bqkv, D, 0.125f * 1.4426950408889634f};
              GEMM_CALL_EpiQK(pg8::gemm_phase<pg8::EpiQK, pg8::StaticOrder, true, true>(lds, g, S, E)); }
            { pg8::Gemm g{(const bf16*)(wl + WO_QKV) + (size_t)2 * D * D, HBc, D, M, D}; pg8::StaticOrder S; S.init(D, M, G, bx);
              pg8::EpiVT E{VT, M, ssq_mix, bqkv ? bqkv + 2 * D : nullptr};
              GEMM_CALL_EpiVT(pg8::gemm_phase<pg8::EpiVT, pg8::StaticOrder, true, true>(lds, g, S, E)); }
        }
        GRID_SYNC();
        { OPQ_TID(); OPQ_LAYER(); const float* pin = P.in[1];
        if (is_da) {
            float d1 = 0.f, d2 = 0.f;
            { const float* q1 = P.in[8] + j * 64; const float* k1 = P.in[9] + j * 64; const float* q2 = P.in[10] + j * 64; const float* k2 = P.in[11] + j * 64;
              d1 = wave_sum(q1[lane] * k1[lane]); d2 = wave_sum(q2[lane] * k2[lane]); }
            const float lam_init = 0.8f - 0.6f * __expf(-0.3f * (float)li);
            const float lam = __expf(d1) - __expf(d2) + lam_init;
#ifndef NO_DA
            float* KN = (float*)(ws + WS_KN);
            att::da_knorm(QK, KN, gw, NGW, lane);
            GRID_SYNC();
            att::da_phase(lds, QK, VT, AO, KN, lam, 1.0f - lam_init, P.in[12] + j * 128, G, bx);
#else
            for (int i = bx * NTHR + tid; i < M * D / 8; i += G * NTHR) ((v4u*)AO)[i] = (v4u){0u, 0u, 0u, 0u};
#endif
        } else {
#ifndef NO_NA
            att::na_phase(lds, QK, VT, AO, P.in[15] + (size_t)j * 16 * 15 * 31, G, bx);
#else
            for (int i = bx * NTHR + tid; i < M * D / 8; i += G * NTHR) ((v4u*)AO)[i] = (v4u){0u, 0u, 0u, 0u};
#endif
        }
#ifdef EXP_TWICE
        if (is_da && li == 0) {
            GRID_SYNC();
            { float d1 = wave_sum(P.in[8][lane] * P.in[9][lane]), d2 = wave_sum(P.in[10][lane] * P.in[11][lane]); const float lam_init = 0.8f - 0.6f * __expf(-0.3f * (float)li);
              att::da_phase(lds, QK, VT, (bf16*)(ws + WS_HB1), (float*)(ws + WS_KN), __expf(d1) - __expf(d2) + lam_init, 1.0f - lam_init, P.in[12], G, bx); }
            GRID_SYNC();
            { const v4u* a = (const v4u*)AO; const v4u* c = (const v4u*)(ws + WS_HB1); unsigned bad = 0;
              for (int i = bx * NTHR + tid; i < M * D / 8; i += G * NTHR) { const v4u u = a[i], w = c[i]; bad |= (u.x ^ w.x) | (u.y ^ w.y) | (u.z ^ w.z) | (u.w ^ w.w); }
              if (bad) __hip_atomic_store((unsigned*)(ws + WS_BAR + 128), 1u, __ATOMIC_RELAXED, __HIP_MEMORY_SCOPE_AGENT); }
        }
#endif
        { const f32x4* src = (const f32x4*)(pin + (size_t)li * M * PLE); v4u* dst = (v4u*)PB;
          const int str_ = G * NTHR;
          for (int i = bx * NTHR + tid; i < M * PLE / 8; i += 4 * str_) { f32x4 a[4], c[4];
#pragma unroll
              for (int k = 0; k < 4; ++k) { const int ii = min(i + k * str_, M * PLE / 8 - 1); a[k] = ((const __attribute__((address_space(1))) f32x4*)src)[2 * ii]; c[k] = ((const __attribute__((address_space(1))) f32x4*)src)[2 * ii + 1]; }
#pragma unroll
              for (int k = 0; k < 4; ++k) { const int ii = i + k * str_; if (ii < M * PLE / 8) { v4u w; w.x = pk2(a[k].x, a[k].y); w.y = pk2(a[k].z, a[k].w); w.z = pk2(c[k].x, c[k].y); w.w = pk2(c[k].z, c[k].w); ((__attribute__((address_space(1))) v4u*)dst)[ii] = w; } } } }
        }
        GRID_SYNC();
        { OPQ_TID(); OPQ_LAYER(); const float* x = P.in[0];
          pg8::Gemm g{AO, (const bf16*)(wl + WO_O), M, D, D}; pg8::StaticOrder S; S.init(M, D, G, bx);
          pg8::EpiResid E{li == 0 ? x : out, out, HBc, ssq_ffn};
          GEMM_CALL_EpiResid(pg8::gemm_phase<pg8::EpiResid, pg8::StaticOrder, true, true>(lds, g, S, E)); }
        GRID_SYNC();
        { OPQ_TID(); OPQ_LAYER();
          pg8::Gemm g{HBc, (const bf16*)(wl + WO_GU), M, 2 * FF, D}; pg8::StaticOrder S; S.init(M, 2 * FF, G, bx);
          pg8::EpiSwiGLU E{HID, ssq_ffn};
          GEMM_CALL_EpiSwiGLU(pg8::gemm_phase<pg8::EpiSwiGLU, pg8::StaticOrder, true, true>(lds, g, S, E)); }
        { OPQ_TID(); OPQ_LAYER();
          pg8::Gemm g{PB, (const bf16*)(wl + WO_PP), M, D, PLE}; pg8::StaticOrder S; S.init(M, D, G, bx);
          pg8::EpiQK E{AO, D, nullptr, nullptr, 0, 1.f};
          GEMM_CALL_EpiQK(pg8::gemm_phase<pg8::EpiQK, pg8::StaticOrder, true, true>(lds, g, S, E)); }
        GRID_SYNC();
        { OPQ_TID(); OPQ_LAYER();
          pg8::Gemm g{HID, (const bf16*)(wl + WO_DN), M, D, FF}; pg8::StaticOrder S; S.init(M, D, G, bx);
          pg8::EpiResid E{out, out, HBc, ssq_ple};
          GEMM_CALL_EpiResid(pg8::gemm_phase<pg8::EpiResid, pg8::StaticOrder, true, true>(lds, g, S, E)); }
        GRID_SYNC();
        { OPQ_TID(); OPQ_LAYER();
          pg8::Gemm g{HBc, (const bf16*)(wl + WO_PG), M, D, D}; pg8::StaticOrder S; S.init(M, D, G, bx);
          pg8::EpiPle E{out, AO, HBn, ssq_ple, ssq_nxt};
          GEMM_CALL_EpiPle(pg8::gemm_phase<pg8::EpiPle, pg8::StaticOrder, true, true>(lds, g, S, E)); }
        GRID_SYNC();
    }
    {
        OPQ_TID(); OPQ_WS(); const float* norm_final = P.in[5];
        const pg8::u64* sq = ssq + (size_t)12 * M;
        typedef __attribute__((address_space(1))) f32x4 gf4;
        f32x4 gg[4];
#pragma unroll
        for (int jj = 0; jj < 4; ++jj) gg[jj] = ((const gf4*)norm_final)[lane + 64 * jj];
        for (int m0 = gw; m0 < M; m0 += 4 * NGW) {
            f32x4 v[4][4]; pg8::u64 q4[4];
#pragma unroll
            for (int k = 0; k < 4; ++k) { const int m = m0 + k * NGW; q4[k] = ((const __attribute__((address_space(1))) pg8::u64*)sq)[m];
#pragma unroll
                for (int jj = 0; jj < 4; ++jj) v[k][jj] = ((const gf4*)(out + (size_t)m * D))[lane + 64 * jj]; }
#pragma unroll
            for (int k = 0; k < 4; ++k) { const int m = m0 + k * NGW; const float rs = pg8::rstd_of(q4[k]);
#pragma unroll
                for (int jj = 0; jj < 4; ++jj) ((gf4*)(out + (size_t)m * D))[lane + 64 * jj] = v[k][jj] * rs * gg[jj]; }
        }
        for (int m = M; m < M; ++m) { f32x4* hr = nullptr; (void)hr;
#ifdef EXP_TWICE
            if (__hip_atomic_load((unsigned*)(ws + WS_BAR + 128), __ATOMIC_RELAXED, __HIP_MEMORY_SCOPE_AGENT)) { const float qn = __builtin_nanf("");
                for (int jj = 0; jj < 4; ++jj) hr[64 * jj] = (f32x4){qn, qn, qn, qn}; }
#endif
        }
    }
}

extern "C" void kernel_launch(void* const* d_in, const int* in_sizes, int n_in, void* d_out, int out_size, void* d_ws, size_t ws_size, hipStream_t stream) {
    static int grid_blocks = 0;
    if (grid_blocks == 0) {
        if (n_in != 22 || out_size != M * D || ws_size < WS_END) { fprintf(stderr, "kernel_launch: unexpected shapes (n_in %d, out %d, ws %zu)\n", n_in, out_size, ws_size); grid_blocks = -1; return; }
        int dev = 0, cus = 0, per_cu = 0;
        hipGetDevice(&dev);
        hipDeviceGetAttribute(&cus, hipDeviceAttributeMultiprocessorCount, dev);
        if (hipFuncSetAttribute((const void*)fwd_megakernel, hipFuncAttributeMaxDynamicSharedMemorySize, LDS_BYTES) != hipSuccess) fprintf(stderr, "kernel_launch: hipFuncSetAttribute failed\n");
        if (hipOccupancyMaxActiveBlocksPerMultiprocessor(&per_cu, (const void*)fwd_megakernel, NTHR, LDS_BYTES) != hipSuccess || per_cu < 1) { fprintf(stderr, "kernel_launch: occupancy query gave %d\n", per_cu); per_cu = 1; }
        (void)hipGetLastError();
        grid_blocks = cus * per_cu;
    }
    if (grid_blocks < 0) return;
    if (hipMemsetAsync((char*)d_ws + WS_BAR, 0, 4096, stream) != hipSuccess) { fprintf(stderr, "kernel_launch: memset failed\n"); return; }
    Params p{};
    for (int i = 0; i < 22; ++i) p.in[i] = (const float*)d_in[i];
    p.out = (float*)d_out; p.ws = (unsigned char*)d_ws;
    void* args[] = {&p};
    hipError_t e = hipLaunchCooperativeKernel((const void*)fwd_megakernel, dim3(grid_blocks), dim3(NTHR), args, LDS_BYTES, stream);
    if (e != hipSuccess) fprintf(stderr, "cooperative launch failed: %s (grid %d)\n", hipGetErrorString(e), grid_blocks);
}
```

```cpp
#ifndef GQ
#define GQ(...) __VA_ARGS__
#endif
#ifndef GV
#define GV(...) __VA_ARGS__
#endif
#ifndef GR
#define GR(...) __VA_ARGS__
#endif
#ifndef GS
#define GS(...) __VA_ARGS__
#endif
#ifndef GP
#define GP(...) __VA_ARGS__
#endif
#define GEMM_CALL_EpiQK(...) GQ(__VA_ARGS__)
#define GEMM_CALL_EpiVT(...) GV(__VA_ARGS__)
#define GEMM_CALL_EpiResid(...) GR(__VA_ARGS__)
#define GEMM_CALL_EpiSwiGLU(...) GS(__VA_ARGS__)
#define GEMM_CALL_EpiPle(...) GP(__VA_ARGS__)
#include <hip/hip_runtime.h>
#include <hip/hip_cooperative_groups.h>
#include <cstdio>
#include <cstdint>
namespace cg = cooperative_groups;
namespace pg8 {
#define PG8_LAS __attribute__((address_space(3)))
typedef unsigned short bf16_t;
typedef short bf16x8 __attribute__((ext_vector_type(8)));
typedef float f32x4 __attribute__((ext_vector_type(4)));
typedef unsigned u32x4 __attribute__((ext_vector_type(4)));
constexpr int BM = 256, BK = 64, HALF = 128, HTB = HALF * BK * 2  , STAGE_BYTES = 8 * HTB, NXCD = 8, WGM = 8;

__host__ __device__ __forceinline__ int lds_byte(int r, int c) { const int st = (r >> 4) * 2 + (c >> 5), rr = r & 15, cc = c & 31, ob = rr * 64 + cc * 2; return st * 1024 + (ob ^ (((ob >> 9) & 1) << 5)); }
__host__ __device__ __forceinline__ void stage_rc(int b, int& R, int& C) { const int st = b / 1024, sb = b % 1024, swz = sb ^ (((sb >> 9) & 1) << 5); R = (st >> 1) * 16 + swz / 64; C = (st & 1) * 32 + (swz % 64) / 2; }
__host__ __device__ __forceinline__ int perm32(int rho) { const int n = rho >> 4, i = rho & 15; return 8 * (i >> 2) + 4 * n + (i & 3); }

struct Unit { int pm, pn; };
struct Gemm { const bf16_t* A; const bf16_t* Bt; int M, N, K; };

struct StaticOrder {
    int nM, nN, nwg, G, c;
    __host__ __device__ void init(int M, int N, int G_, int c_) { nM = M / BM; nN = N / BM; nwg = nM * nN; G = G_; c = c_; }
    __host__ __device__ bool next(int i, Unit& u) const {
        const long L = (long)i * G + c; if (L >= nwg) return false;
        int wgid = (int)L; { const int q = nwg / NXCD, r = nwg % NXCD, xcd = wgid % NXCD, off = wgid / NXCD; wgid = (xcd < r ? xcd * (q + 1) : r * (q + 1) + (xcd - r) * q) + off; }
        const int nig = WGM * nN, gid = wgid / nig, fm = gid * WGM, gsz = (nM - fm) < WGM ? (nM - fm) : WGM;
        u.pm = fm + ((wgid % nig) % gsz); u.pn = (wgid % nig) / gsz; return true;
    }
    __device__ __forceinline__ void a_ready(const Unit&) const {}
    __device__ __forceinline__ void done(const Unit&) const {}
};

__device__ __forceinline__ unsigned cvt_pk_bf16(float lo, float hi) { unsigned r; asm volatile("v_cvt_pk_bf16_f32 %0, %1, %2" : "=v"(r) : "v"(lo), "v"(hi)); return r; }
typedef float f32x2 __attribute__((ext_vector_type(2)));
typedef unsigned u32x2 __attribute__((ext_vector_type(2)));
#define PG8_GAS __attribute__((address_space(1)))
constexpr float LOG2E = 1.4426950408889634f;
typedef unsigned long long u64;
constexpr float SSQ_FIX = 1048576.0f;
__device__ __forceinline__ float rstd_of(u64 q) { return rsqrtf((float)q * (1.0f / (SSQ_FIX * 1024.0f)) + 1e-6f); }
__device__ __forceinline__ float rstd_row(const u64* ssq, int row) { return rstd_of(((const PG8_GAS u64*)ssq)[row]); }
__device__ __forceinline__ float sigm(float a) { return __builtin_amdgcn_rcpf(1.0f + __builtin_amdgcn_exp2f(-a * LOG2E)); }
__device__ __forceinline__ void atomic_addf(u64* p, float v) { __hip_atomic_fetch_add((PG8_GAS u64*)p, (u64)(v * SSQ_FIX + 0.5f), __ATOMIC_RELAXED, __HIP_MEMORY_SCOPE_AGENT); }

struct EpiQK {
    static constexpr bool PERM = true, AFTER_DRAIN = false;
    bf16_t* O; int ldc; const u64* ssq; const float* bias; int qcols; float qscale;
    __device__ __forceinline__ void operator()(const f32x4 (&acc)[2][2][4][2], const Unit& u, int wr, int wc, int fr, int fq) const {
        const int row0 = u.pm * BM + wr * 64 + fr, col0 = u.pn * BM + wc * 32 + 8 * fq;
        const float sc = (u.pn * BM < qcols) ? qscale : 1.f;
        f32x4 bv[2][2];
#pragma unroll
        for (int bj = 0; bj < 2; ++bj)
#pragma unroll
            for (int n = 0; n < 2; ++n) bv[bj][n] = bias ? *(const PG8_GAS f32x4*)(bias + col0 + bj * HALF + 4 * n) : (f32x4){0.f, 0.f, 0.f, 0.f};
#pragma unroll
        for (int ai = 0; ai < 2; ++ai)
#pragma unroll
            for (int m = 0; m < 4; ++m) { const int row = row0 + ai * HALF + m * 16; const float rs = ssq ? rstd_row(ssq, row) : 1.f; bf16_t* rowp = O + (size_t)row * ldc + col0;
#pragma unroll
                for (int bj = 0; bj < 2; ++bj) { const f32x4 v0 = (acc[ai][bj][m][0] * rs + bv[bj][0]) * sc, v1 = (acc[ai][bj][m][1] * rs + bv[bj][1]) * sc;
                    u32x4 w; w.x = cvt_pk_bf16(v0[0], v0[1]); w.y = cvt_pk_bf16(v0[2], v0[3]); w.z = cvt_pk_bf16(v1[0], v1[1]); w.w = cvt_pk_bf16(v1[2], v1[3]);
                    *(PG8_GAS u32x4*)(rowp + bj * HALF) = w; } }
    }
};
struct EpiVT {
    static constexpr bool PERM = true, AFTER_DRAIN = false;
    bf16_t* O; int ldc; const u64* ssq; const float* bias;
    __device__ __forceinline__ void operator()(const f32x4 (&acc)[2][2][4][2], const Unit& u, int wr, int wc, int fr, int fq) const {
        const int row0 = u.pm * BM + wr * 64 + fr, col0 = u.pn * BM + wc * 32 + 8 * fq;
        f32x4 rs[2][2];
#pragma unroll
        for (int bj = 0; bj < 2; ++bj)
#pragma unroll
            for (int n = 0; n < 2; ++n) {
#pragma unroll
                for (int i = 0; i < 4; ++i) rs[bj][n][i] = rstd_of(((const PG8_GAS u64*)ssq)[col0 + bj * HALF + 4 * n + i]); }
#pragma unroll
        for (int ai = 0; ai < 2; ++ai)
#pragma unroll
            for (int m = 0; m < 4; ++m) { const int row = row0 + ai * HALF + m * 16; const float bb = bias ? ((const PG8_GAS float*)bias)[row] : 0.f; bf16_t* rowp = O + (size_t)row * ldc + col0;
#pragma unroll
                for (int bj = 0; bj < 2; ++bj) { const f32x4 v0 = acc[ai][bj][m][0] * rs[bj][0] + bb, v1 = acc[ai][bj][m][1] * rs[bj][1] + bb;
                    u32x4 w; w.x = cvt_pk_bf16(v0[0], v0[1]); w.y = cvt_pk_bf16(v0[2], v0[3]); w.z = cvt_pk_bf16(v1[0], v1[1]); w.w = cvt_pk_bf16(v1[2], v1[3]);
                    *(PG8_GAS u32x4*)(rowp + bj * HALF) = w; } }
    }
};
struct EpiResid {
    static constexpr bool PERM = false, AFTER_DRAIN = false;
    const float* base; float* out; bf16_t* hb; u64* ssq_next;
    __device__ __forceinline__ void operator()(const f32x4 (&acc)[2][2][4][2], const Unit& u, int wr, int wc, int fr, int fq) const {
        const int row0 = u.pm * BM + wr * 64 + fr, col0 = u.pn * BM + wc * 32 + 4 * fq;
#pragma unroll
        for (int am = 0; am < 4; ++am) { const int ai = am >> 1, m0 = (am & 1) * 2;
            f32x4 bs[4][2][2];
#pragma unroll
            for (int m = m0; m < m0 + 2; ++m) { const size_t off0 = (size_t)(row0 + ai * HALF + m * 16) * 1024 + col0;
#pragma unroll
                for (int bj = 0; bj < 2; ++bj)
#pragma unroll
                    for (int n = 0; n < 2; ++n) bs[m][bj][n] = *(const PG8_GAS f32x4*)(base + off0 + bj * HALF + n * 16); }
            asm volatile("" ::: "memory");
#pragma unroll
            for (int m = m0; m < m0 + 2; ++m) { const int row = row0 + ai * HALF + m * 16; const size_t off0 = (size_t)row * 1024 + col0; float ss = 0.f;
#pragma unroll
                for (int bj = 0; bj < 2; ++bj)
#pragma unroll
                    for (int n = 0; n < 2; ++n) { const size_t off = off0 + bj * HALF + n * 16; const f32x4 v = bs[m][bj][n] + acc[ai][bj][m][n];
                        *(PG8_GAS f32x4*)(out + off) = v; u32x2 w; w.x = cvt_pk_bf16(v[0], v[1]); w.y = cvt_pk_bf16(v[2], v[3]); *(PG8_GAS u32x2*)(hb + off) = w;
                        ss += (v[0] * v[0] + v[1] * v[1]) + (v[2] * v[2] + v[3] * v[3]); }
                ss += __shfl_xor(ss, 16); ss += __shfl_xor(ss, 32);
                if (fq == 0) atomic_addf(ssq_next + row, ss); }
            asm volatile("" ::: "memory");
        }
    }
};
struct EpiSwiGLU {
    static constexpr bool PERM = true, AFTER_DRAIN = false;
    bf16_t* O; const u64* ssq;
    __device__ __forceinline__ void operator()(const f32x4 (&acc)[2][2][4][2], const Unit& u, int wr, int wc, int fr, int fq) const {
        const int row0 = u.pm * BM + wr * 64 + fr, colh = u.pn * HALF + wc * 32 + 8 * fq;
#pragma unroll
        for (int ai = 0; ai < 2; ++ai)
#pragma unroll
            for (int m = 0; m < 4; ++m) { const int row = row0 + ai * HALF + m * 16; const float rs = rstd_row(ssq, row); f32x4 r[2];
#pragma unroll
                for (int n = 0; n < 2; ++n) { const f32x4 g = acc[ai][0][m][n] * rs, up = acc[ai][1][m][n] * rs;
#pragma unroll
                    for (int i = 0; i < 4; ++i) r[n][i] = g[i] * sigm(g[i]) * up[i]; }
                u32x4 w; w.x = cvt_pk_bf16(r[0][0], r[0][1]); w.y = cvt_pk_bf16(r[0][2], r[0][3]); w.z = cvt_pk_bf16(r[1][0], r[1][1]); w.w = cvt_pk_bf16(r[1][2], r[1][3]);
                *(PG8_GAS u32x4*)(O + (size_t)row * 2816 + colh) = w; }
    }
};
struct EpiPle {
    static constexpr bool PERM = false, AFTER_DRAIN = false;
    float* h; const bf16_t* proj; bf16_t* hb; const u64* ssq_in; u64* ssq_next;
    __device__ __forceinline__ void operator()(const f32x4 (&acc)[2][2][4][2], const Unit& u, int wr, int wc, int fr, int fq) const {
        const int row0 = u.pm * BM + wr * 64 + fr, col0 = u.pn * BM + wc * 32 + 4 * fq;
#pragma unroll
        for (int am = 0; am < 4; ++am) { const int ai = am >> 1, m0 = (am & 1) * 2;
            f32x4 hs[4][2][2]; u32x2 ps[4][2][2]; u64 sq[4];
#pragma unroll
            for (int m = m0; m < m0 + 2; ++m) { const int row = row0 + ai * HALF + m * 16; const size_t off0 = (size_t)row * 1024 + col0; sq[m] = ((const PG8_GAS u64*)ssq_in)[row];
#pragma unroll
                for (int bj = 0; bj < 2; ++bj)
#pragma unroll
                    for (int n = 0; n < 2; ++n) { hs[m][bj][n] = *(const PG8_GAS f32x4*)(h + off0 + bj * HALF + n * 16); ps[m][bj][n] = *(const PG8_GAS u32x2*)(proj + off0 + bj * HALF + n * 16); } }
            asm volatile("" ::: "memory");
#pragma unroll
            for (int m = m0; m < m0 + 2; ++m) { const int row = row0 + ai * HALF + m * 16; const size_t off0 = (size_t)row * 1024 + col0; const float rs = rstd_of(sq[m]); float ss = 0.f;
#pragma unroll
                for (int bj = 0; bj < 2; ++bj)
#pragma unroll
                    for (int n = 0; n < 2; ++n) { const size_t off = off0 + bj * HALF + n * 16; const u32x2 pw = ps[m][bj][n]; const f32x4 a = acc[ai][bj][m][n] * rs;
                        f32x4 pr; pr[0] = __uint_as_float(pw.x << 16); pr[1] = __uint_as_float(pw.x & 0xffff0000u); pr[2] = __uint_as_float(pw.y << 16); pr[3] = __uint_as_float(pw.y & 0xffff0000u);
                        f32x4 v = hs[m][bj][n];
#pragma unroll
                        for (int i = 0; i < 4; ++i) v[i] += sigm(a[i]) * pr[i];
                        *(PG8_GAS f32x4*)(h + off) = v; u32x2 w; w.x = cvt_pk_bf16(v[0], v[1]); w.y = cvt_pk_bf16(v[2], v[3]); *(PG8_GAS u32x2*)(hb + off) = w;
                        ss += (v[0] * v[0] + v[1] * v[1]) + (v[2] * v[2] + v[3] * v[3]); }
                ss += __shfl_xor(ss, 16); ss += __shfl_xor(ss, 32);
                if (fq == 0) atomic_addf(ssq_next + row, ss); }
            asm volatile("" ::: "memory");
        }
    }
};
template <class Epi, class Sched, bool ALIGN_EPI = false, bool SP2 = false>
__device__ __forceinline__ void gemm_phase(PG8_LAS unsigned char* lds, const Gemm g, const Sched& S, const Epi& E) {
    int tid_ = threadIdx.x; asm volatile("" : "+v"(tid_));
    const int tid = tid_, wid = __builtin_amdgcn_readfirstlane(tid >> 6), lane = tid & 63, wr = wid >> 2, wc = wid & 3, fr = lane & 15, fq = lane >> 4;
    const int K = g.K, nt = K / BK;
    unsigned voffA[2], voffB[2];
#pragma unroll
    for (int i = 0; i < 2; ++i) { int R, C; stage_rc(tid * 16 + i * 8192, R, C); const int Rb = Epi::PERM ? ((R & ~31) + perm32(R & 31)) : R;
        voffA[i] = (unsigned)(R * K + C) * 2u; voffB[i] = (unsigned)(Rb * K + C) * 2u; }
    const size_t kstep = (size_t)(BK * 2);
    const size_t hstep = (size_t)HALF * K * 2;
    const size_t tstep = 2 * hstep;
    const unsigned ldsw = (unsigned)wid * 1024u;
    const int aoff = lds_byte(wr * 64 + fr, fq * 8), boff = lds_byte(wc * 32 + fr, fq * 8);
#define PG8_SA(b, h) (((b) * 2 + (h)) * HTB)
#define PG8_SB(b, h) ((4 + (b) * 2 + (h)) * HTB)
#define PG8_STAGE(bufoff, gbase, voff) do { _Pragma("unroll") for (int _i = 0; _i < 2; ++_i) \
        __builtin_amdgcn_global_load_lds((const unsigned*)((const char*)(gbase) + (voff)[_i]), (PG8_LAS unsigned*)(lds + (bufoff) + ldsw + _i * 8192), 16, 0, 0); } while (0)
#define PG8_LDA(dst, b, h) do { _Pragma("unroll") for (int m = 0; m < 4; ++m) _Pragma("unroll") for (int k = 0; k < 2; ++k) dst[m][k] = *(const PG8_LAS bf16x8*)(lds + PG8_SA(b, h) + aoff + m * 2048 + k * 1024); } while (0)
#define PG8_LDB(dst, b, h) do { _Pragma("unroll") for (int n = 0; n < 2; ++n) _Pragma("unroll") for (int k = 0; k < 2; ++k) dst[n][k] = *(const PG8_LAS bf16x8*)(lds + PG8_SB(b, h) + boff + n * 2048 + k * 1024); } while (0)
#define PG8_MMA(ai, bj, At, Bt) do { __builtin_amdgcn_s_setprio(1); _Pragma("unroll") for (int m = 0; m < 4; ++m) _Pragma("unroll") for (int n = 0; n < 2; ++n) _Pragma("unroll") for (int k = 0; k < 2; ++k) \
        acc[ai][bj][m][n] = __builtin_amdgcn_mfma_f32_16x16x32_bf16(Bt[n][k], At[m][k], acc[ai][bj][m][n], 0, 0, 0); __builtin_amdgcn_s_setprio(0); } while (0)
#define PG8_WAIT_V(n) asm volatile("s_waitcnt vmcnt(" #n ")" ::: "memory")
#define PG8_WAIT_L(n) asm volatile("s_waitcnt lgkmcnt(" #n ")" ::: "memory")
#define PG8_BAR __builtin_amdgcn_s_barrier()
#define PG8_SCHED __builtin_amdgcn_sched_barrier(0)
    Unit cur, nxt; int ui = 0;
    if (!S.next(0, cur)) return;
    f32x4 acc[2][2][4][2];
#pragma unroll
    for (int a = 0; a < 2; ++a)
#pragma unroll
        for (int b = 0; b < 2; ++b)
#pragma unroll
            for (int m = 0; m < 4; ++m)
#pragma unroll
                for (int n = 0; n < 2; ++n) acc[a][b][m][n] = (f32x4){0.f, 0.f, 0.f, 0.f};
    bf16x8 At[4][2], B0[2][2], B1[2][2];
    const char* cA = (const char*)g.A + (size_t)cur.pm * tstep; const char* cB = (const char*)g.Bt + (size_t)cur.pn * tstep;
    S.a_ready(cur);
    if constexpr (SP2) {
        PG8_STAGE(PG8_SB(0, 0), cB, voffB); PG8_STAGE(PG8_SB(0, 1), cB + hstep, voffB); PG8_STAGE(PG8_SA(0, 0), cA, voffA); PG8_STAGE(PG8_SA(0, 1), cA + hstep, voffA);
        if (wr == 1) PG8_BAR;
        PG8_WAIT_V(2); PG8_BAR;
        PG8_STAGE(PG8_SB(1, 0), cB + kstep, voffB); PG8_STAGE(PG8_SA(1, 0), cA + kstep, voffA); PG8_STAGE(PG8_SB(1, 1), cB + hstep + kstep, voffB);
        PG8_WAIT_V(6); PG8_BAR;
    } else {
        PG8_STAGE(PG8_SB(0, 0), cB, voffB); PG8_STAGE(PG8_SA(0, 0), cA, voffA); PG8_STAGE(PG8_SB(0, 1), cB + hstep, voffB); PG8_STAGE(PG8_SA(0, 1), cA + hstep, voffA);
        if (wr == 1) PG8_BAR;
        PG8_WAIT_V(4); PG8_BAR;
        PG8_STAGE(PG8_SB(1, 0), cB + kstep, voffB); PG8_STAGE(PG8_SA(1, 0), cA + kstep, voffA); PG8_STAGE(PG8_SB(1, 1), cB + hstep + kstep, voffB);
        PG8_WAIT_V(6); PG8_BAR;
    }
    for (;;) {
        const bool has_next = S.next(ui + 1, nxt);
        const char* nA = has_next ? (const char*)g.A + (size_t)nxt.pm * tstep : cA; const char* nB = has_next ? (const char*)g.Bt + (size_t)nxt.pn * tstep : cB;
        for (int t = 0; t < nt; t += 2) {
            const bool last = (t == nt - 2);
            const char* a1 = cA + (size_t)(t + 1) * kstep;
            const char* a2 = last ? nA : cA + (size_t)(t + 2) * kstep; const char* b2 = last ? nB : cB + (size_t)(t + 2) * kstep;
            const char* a3 = a2 + kstep; const char* b3 = b2 + kstep;
            if (last && has_next) S.a_ready(nxt);
            if constexpr (SP2) {
            PG8_LDB(B0, 0, 0); PG8_LDB(B1, 0, 1); PG8_SCHED; PG8_LDA(At, 0, 0); PG8_STAGE(PG8_SA(1, 1), a1 + hstep, voffA);
            PG8_WAIT_V(8); PG8_WAIT_L(0); PG8_BAR; PG8_MMA(0, 0, At, B0); PG8_MMA(0, 1, At, B1); PG8_BAR; PG8_SCHED;
            PG8_LDA(At, 0, 1); PG8_STAGE(PG8_SB(0, 0), b2, voffB); PG8_STAGE(PG8_SB(0, 1), b2 + hstep, voffB); PG8_STAGE(PG8_SA(0, 0), a2, voffA);
            PG8_WAIT_V(8); PG8_WAIT_L(0); PG8_BAR; PG8_MMA(1, 0, At, B0); PG8_MMA(1, 1, At, B1); PG8_BAR; PG8_SCHED;
            PG8_LDB(B0, 1, 0); PG8_LDB(B1, 1, 1); PG8_SCHED; PG8_LDA(At, 1, 0); PG8_STAGE(PG8_SA(0, 1), a2 + hstep, voffA);
            PG8_WAIT_V(8); PG8_WAIT_L(0); PG8_BAR; PG8_MMA(0, 0, At, B0); PG8_MMA(0, 1, At, B1); PG8_BAR; PG8_SCHED;
            PG8_LDA(At, 1, 1); PG8_STAGE(PG8_SB(1, 0), b3, voffB); PG8_STAGE(PG8_SB(1, 1), b3 + hstep, voffB); PG8_STAGE(PG8_SA(1, 0), a3, voffA);
            PG8_WAIT_V(8); PG8_WAIT_L(0); PG8_BAR; PG8_MMA(1, 0, At, B0); PG8_MMA(1, 1, At, B1); PG8_BAR; PG8_SCHED;
            } else {
            PG8_LDB(B0, 0, 0); PG8_SCHED; PG8_LDA(At, 0, 0); PG8_STAGE(PG8_SA(1, 1), a1 + hstep, voffA);
            PG8_WAIT_L(8); PG8_BAR; PG8_WAIT_L(0); PG8_MMA(0, 0, At, B0); PG8_BAR; PG8_SCHED;
            PG8_LDB(B1, 0, 1); PG8_STAGE(PG8_SB(0, 0), b2, voffB);
            PG8_BAR; PG8_WAIT_L(0); PG8_MMA(0, 1, At, B1); PG8_BAR;
            PG8_LDA(At, 0, 1); PG8_STAGE(PG8_SA(0, 0), a2, voffA);
            PG8_BAR; PG8_WAIT_L(0); PG8_MMA(1, 0, At, B0); PG8_BAR; PG8_SCHED;
            PG8_STAGE(PG8_SB(0, 1), b2 + hstep, voffB);
            PG8_WAIT_V(6); PG8_BAR; PG8_MMA(1, 1, At, B1); PG8_BAR;
            PG8_LDB(B0, 1, 0); PG8_SCHED; PG8_LDA(At, 1, 0); PG8_STAGE(PG8_SA(0, 1), a2 + hstep, voffA);
            PG8_WAIT_L(8); PG8_BAR; PG8_WAIT_L(0); PG8_MMA(0, 0, At, B0); PG8_BAR; PG8_SCHED;
            PG8_LDB(B1, 1, 1); PG8_STAGE(PG8_SB(1, 0), b3, voffB);
            PG8_BAR; PG8_WAIT_L(0); PG8_MMA(0, 1, At, B1); PG8_BAR;
            PG8_LDA(At, 1, 1); PG8_STAGE(PG8_SA(1, 0), a3, voffA);
            PG8_BAR; PG8_WAIT_L(0); PG8_MMA(1, 0, At, B0); PG8_BAR; PG8_SCHED;
            PG8_STAGE(PG8_SB(1, 1), b3 + hstep, voffB);
            PG8_WAIT_V(6); PG8_BAR; PG8_MMA(1, 1, At, B1); PG8_BAR;
            }
        }
        if constexpr (ALIGN_EPI) { if (wr == 0) PG8_BAR; }
        if constexpr (!Epi::AFTER_DRAIN) { E(acc, cur, wr, wc, fr, fq); S.done(cur); }
        if (!has_next) break;
#pragma unroll
        for (int a = 0; a < 2; ++a)
#pragma unroll
            for (int b = 0; b < 2; ++b)
#pragma unroll
                for (int m = 0; m < 4; ++m)
#pragma unroll
                    for (int n = 0; n < 2; ++n) acc[a][b][m][n] = (f32x4){0.f, 0.f, 0.f, 0.f};
        cur = nxt; cA = nA; cB = nB; ++ui;
        if constexpr (ALIGN_EPI) { if (wr == 1) PG8_BAR; }
    }
    PG8_WAIT_V(0);
    if constexpr (!ALIGN_EPI) { if (wr == 0) PG8_BAR; }
    PG8_BAR;
    if constexpr (Epi::AFTER_DRAIN) { E.fused(acc, cur, wr, wc, fr, fq, lds, wid, lane); S.done(cur); }
#undef PG8_SA
#undef PG8_SB
#undef PG8_STAGE
#undef PG8_LDA
#undef PG8_LDB
#undef PG8_MMA
#undef PG8_WAIT_V
#undef PG8_WAIT_L
#undef PG8_BAR
#undef PG8_SCHED
}
}
namespace att {
#define LAS __attribute__((address_space(3)))
typedef unsigned short bf16_t;
typedef short bf16x8 __attribute__((ext_vector_type(8)));
typedef float f32x4 __attribute__((ext_vector_type(4)));
typedef float f32x16 __attribute__((ext_vector_type(16)));
typedef unsigned u32x4 __attribute__((ext_vector_type(4)));
typedef unsigned u32x2 __attribute__((ext_vector_type(2)));
typedef float f32x2_t __attribute__((ext_vector_type(2))); typedef __bf16 bf16x2_t __attribute__((ext_vector_type(2)));
constexpr float LOG2E = 1.4426950408889634f;
constexpr int SEQ = 4096, MTOK = 65536;
__device__ __forceinline__ unsigned cvtpk(float lo, float hi) { f32x2_t v = {lo, hi}; bf16x2_t b = __builtin_convertvector(v, bf16x2_t); return __builtin_bit_cast(unsigned, b); }

#define GAS __attribute__((address_space(1)))
__device__ __forceinline__ void da_knorm(const bf16_t* QK_, float* kn_, int gw, int NGW, int lane) {
    const GAS bf16_t* QK = (const GAS bf16_t*)QK_; GAS float* kn = (GAS float*)kn_;
    for (int task = gw; task < 16 * 8 * 64; task += NGW) {
        const int b = task >> 9, h = (task >> 6) & 7, t = task & 63;
        const GAS u32x4* p = (const GAS u32x4*)(QK + ((size_t)b * SEQ + t * 64 + lane) * 2048 + 1024 + h * 128);
        float a[2] = {0.f, 0.f};
#pragma unroll
        for (int c = 0; c < 16; ++c) { const u32x4 w = p[c];
#pragma unroll
            for (int i = 0; i < 4; ++i) { const float lo = __uint_as_float(w[i] << 16), hi = __uint_as_float(w[i] & 0xffff0000u); a[c >> 3] += lo * lo + hi * hi; } }
        float m = __builtin_fmaxf(a[0], a[1]);
#pragma unroll
        for (int o = 1; o < 64; o <<= 1) m = __builtin_fmaxf(m, __shfl_xor(m, o));
        if (lane == 0) kn[task] = __builtin_sqrtf(m) * 1.002f;
    }
}
__device__ __forceinline__ void da_phase(LAS unsigned char* lds, const bf16_t* QK_, const bf16_t* VT_, bf16_t* AO_, const float* kn_,
                                         float lam, float outscale, const float* subln_, int G, int bx) {
    int tid_ = threadIdx.x; asm volatile("" : "+v"(tid_));
    const int tid = tid_, lane = tid & 63, wid = __builtin_amdgcn_readfirstlane(tid >> 6), q = lane & 31, hi = lane >> 5, mp = wid >> 2, wq = wid & 3;
    const GAS bf16_t* QK = (const GAS bf16_t*)QK_; const GAS bf16_t* VT = (const GAS bf16_t*)VT_; GAS bf16_t* AO = (GAS bf16_t*)AO_; const GAS float* kn = (const GAS float*)kn_; const GAS float* subln = (const GAS float*)subln_;
    const int pi = (q & ~12) | ((q & 8) >> 1) | ((q & 4) << 1);
    unsigned rk[4], rv[4];
#pragma unroll
    for (int s = 0; s < 4; ++s) { const int ck = 2 * s + hi; rk[s] = mp * 8192 + ck * 1024 + (pi ^ ck) * 16; }
#pragma unroll
    for (int jv = 0; jv < 4; ++jv) { const int cv = 2 * jv + hi; rv[jv] = 16384 + cv * 2048 + (q ^ cv) * 16; }
    const int kr = tid >> 4, kch = tid & 15, vd = tid >> 3, vc = tid & 7;
    const unsigned kdst = (kch >> 3) * 8192 + (kch & 7) * 1024 + (kr ^ (kch & 7)) * 16, vdst = 16384 + vc * 2048 + (vd ^ vc) * 16;
    LAS float* xch = (LAS float*)(lds + 65536) + wq * 4096 + lane;
    LAS float* red = (LAS float*)(lds + 131072);
    for (int un = bx; un < 4096; un += G) {
        int b, h, qb; if (G == 256) { const int k = un >> 8; b = k; h = (bx + k) & 7; qb = ((bx >> 3) + 16 * (k & 1)) & 31; } else { b = un >> 8; h = (un >> 5) & 7; qb = un & 31; }
        const float nslope2 = -__builtin_amdgcn_exp2f(-(float)(h + 1)) * LOG2E;
        const size_t tokb = (size_t)b * SEQ;
        const int qpos = qb * 128 + wq * 32 + q;
        const GAS bf16_t* ksrc = QK + (tokb + kr) * 2048 + 1024 + h * 128 + kch * 8;
        const GAS bf16_t* vsrc = VT + (size_t)(h * 128 + vd) * MTOK + tokb + vc * 8;
        u32x4 sa0, sa1, sa2, sa3, sb0, sb1, sb2, sb3;
#define DA_LOADT(S, t) do { S##0 = *(const GAS u32x4*)(ksrc + (size_t)(t) * 64 * 2048); S##1 = *(const GAS u32x4*)(ksrc + (size_t)(t) * 64 * 2048 + 32 * 2048); \
                         S##2 = *(const GAS u32x4*)(vsrc + (t) * 64); S##3 = *(const GAS u32x4*)(vsrc + (size_t)64 * MTOK + (t) * 64); } while (0)
#define DA_STORET(S, bo) do { *(LAS u32x4*)(lds + (bo) + kdst) = S##0; *(LAS u32x4*)(lds + (bo) + kdst + 512) = S##1; *(LAS u32x4*)(lds + (bo) + vdst) = S##2; *(LAS u32x4*)(lds + (bo) + vdst + 1024) = S##3; } while (0)
        const int d0 = 2 * qb, d1 = 2 * qb + 1;
        DA_LOADT(sa, d0); DA_LOADT(sb, d1);
        bf16x8 qf[4]; float qn2 = 0.f;
        { const GAS bf16_t* qp = QK + (tokb + qpos) * 2048 + h * 128 + mp * 64 + 8 * hi;
#pragma unroll
          for (int s = 0; s < 4; ++s) { qf[s] = *(const GAS bf16x8*)(qp + 16 * s);
#pragma unroll
              for (int i = 0; i < 8; ++i) { const float v = __uint_as_float(((unsigned)(unsigned short)qf[s][i]) << 16); qn2 += v * v; } } }
        qn2 += __shfl_xor(qn2, 32);
        const float knl = kn[(b * 8 + h) * 64 + lane];
        f32x16 o[4];
#pragma unroll
        for (int d = 0; d < 4; ++d) o[d] = f32x16{};
        float mref = 0.f, l = 0.f;
#define DA_COMPUTE(t, bo, FIRST, LIN) do { \
            f32x16 p[2]; \
            const float dbase = (float)((t) * 64 + 8 * hi - qpos); \
            const float sg_ = ((t) < d0) ? -nslope2 : nslope2, A_ = dbase * sg_ - mref;     \
            _Pragma("unroll") for (int hf = 0; hf < 2; ++hf) { \
                if (LIN) { _Pragma("unroll") for (int r = 0; r < 16; ++r) p[hf][r] = __builtin_fmaf((float)(32 * hf + 16 * (r >> 3) + (r & 7)), sg_, A_); } \
                else { _Pragma("unroll") for (int r = 0; r < 16; ++r) p[hf][r] = __builtin_fmaf(__builtin_fabsf(dbase + (float)(32 * hf + 16 * (r >> 3) + (r & 7))), nslope2, -mref); } } \
              \
            _Pragma("unroll") for (int s = 0; s < 4; ++s) _Pragma("unroll") for (int hf = 0; hf < 2; ++hf) { \
                const bf16x8 kf = *(const LAS bf16x8*)(lds + (bo) + rk[s] + hf * 512); p[hf] = __builtin_amdgcn_mfma_f32_32x32x16_bf16(kf, qf[s], p[hf], 0, 0, 0); } \
            float mx = p[0][0]; \
            _Pragma("unroll") for (int r = 1; r < 16; ++r) mx = __builtin_fmaxf(mx, p[0][r]); \
            _Pragma("unroll") for (int r = 0; r < 16; ++r) mx = __builtin_fmaxf(mx, p[1][r]); \
            mx = __builtin_fmaxf(mx, __shfl_xor(mx, 32)); \
              \
            if (!(FIRST) && !__any(mx > -36.0f)) break; \
            if (FIRST) { mref = mx; \
                _Pragma("unroll") for (int r = 0; r < 16; ++r) { p[0][r] -= mx; p[1][r] -= mx; } } \
            else if (__any(mx > 8.0f)) { const float dl = __builtin_fmaxf(mx, 0.f); mref += dl; const float f = __builtin_amdgcn_exp2f(-dl); l *= f; \
                _Pragma("unroll") for (int r = 0; r < 16; ++r) { p[0][r] -= dl; p[1][r] -= dl; } \
                _Pragma("unroll") for (int d = 0; d < 4; ++d) _Pragma("unroll") for (int r = 0; r < 16; ++r) o[d][r] *= f; } \
              \
            float sacc = 0.f; bf16x8 pf[2][2]; \
            _Pragma("unroll") for (int r = 0; r < 16; ++r) { p[0][r] = __builtin_amdgcn_exp2f(p[0][r]); sacc += p[0][r]; } \
            _Pragma("unroll") for (int u = 0; u < 2; ++u) { u32x4 w; w.x = cvtpk(p[0][8 * u], p[0][8 * u + 1]); w.y = cvtpk(p[0][8 * u + 2], p[0][8 * u + 3]); \
                    w.z = cvtpk(p[0][8 * u + 4], p[0][8 * u + 5]); w.w = cvtpk(p[0][8 * u + 6], p[0][8 * u + 7]); pf[0][u] = __builtin_bit_cast(bf16x8, w); } \
            _Pragma("unroll") for (int u = 0; u < 2; ++u) _Pragma("unroll") for (int d = 0; d < 4; ++d) { \
                    const bf16x8 vf = *(const LAS bf16x8*)(lds + (bo) + rv[u] + d * 512); o[d] = __builtin_amdgcn_mfma_f32_32x32x16_bf16(vf, pf[0][u], o[d], 0, 0, 0); } \
            _Pragma("unroll") for (int r = 0; r < 16; ++r) { p[1][r] = __builtin_amdgcn_exp2f(p[1][r]); sacc += p[1][r]; } \
            _Pragma("unroll") for (int u = 0; u < 2; ++u) { u32x4 w; w.x = cvtpk(p[1][8 * u], p[1][8 * u + 1]); w.y = cvtpk(p[1][8 * u + 2], p[1][8 * u + 3]); \
                    w.z = cvtpk(p[1][8 * u + 4], p[1][8 * u + 5]); w.w = cvtpk(p[1][8 * u + 6], p[1][8 * u + 7]); pf[1][u] = __builtin_bit_cast(bf16x8, w); } \
            _Pragma("unroll") for (int i_ = 0; i_ < 8; ++i_) { __builtin_amdgcn_sched_group_barrier(0x100, 1, 0); __builtin_amdgcn_sched_group_barrier(0x008, 1, 0); __builtin_amdgcn_sched_group_barrier(0x002, 5, 0); } \
            l += sacc; \
            _Pragma("unroll") for (int u = 0; u < 2; ++u) _Pragma("unroll") for (int d = 0; d < 4; ++d) { \
                    const bf16x8 vf = *(const LAS bf16x8*)(lds + (bo) + rv[2 + u] + d * 512); o[d] = __builtin_amdgcn_mfma_f32_32x32x16_bf16(vf, pf[1][u], o[d], 0, 0, 0); } \
        } while (0)
        DA_STORET(sa, 0);
        __syncthreads();
        DA_COMPUTE(d0, 0, true, false);
        DA_STORET(sb, 32768);
        __syncthreads();
        DA_COMPUTE(d1, 32768, false, false);
        { float lmin = mref, qmx = qn2;
#pragma unroll
          for (int o_ = 1; o_ < 64; o_ <<= 1) { lmin = __builtin_fminf(lmin, __shfl_xor(lmin, o_)); qmx = __builtin_fmaxf(qmx, __shfl_xor(qmx, o_)); }
          if (lane == 0) { red[2 * wid] = lmin; red[2 * wid + 1] = qmx; } }
        __syncthreads();
        unsigned long long mask;
        { float Lmin = red[0], Q2 = red[1];
#pragma unroll
          for (int w = 1; w < 8; ++w) { Lmin = __builtin_fminf(Lmin, red[2 * w]); Q2 = __builtin_fmaxf(Q2, red[2 * w + 1]); }
          const float Qmax = __builtin_sqrtf(Q2) * 1.002f;
          const int t = lane, mind = (t < d0) ? (qb * 128 - (t * 64 + 63)) : (t * 64 - (qb * 128 + 127));
          const float bound = Qmax * knl + nslope2 * (float)mind;
          const bool need = (t != d0) && (t != d1) && (bound >= Lmin - 36.0f);
          mask = __ballot(need); }
        if (mask) {
#define DA_POP(v) do { v = -1; if (mask) { v = (int)__builtin_ctzll(mask); mask &= mask - 1; } } while (0)
            int cur, n1, n2; DA_POP(cur); DA_POP(n1);
            unsigned bo = 0;
            DA_LOADT(sa, cur); DA_LOADT(sb, (n1 >= 0 ? n1 : cur));
            DA_STORET(sa, 0);
            __syncthreads();
#define DA_STEP(X, Y) { DA_POP(n2); DA_LOADT(Y, (n2 >= 0 ? n2 : cur)); DA_COMPUTE(cur, bo, false, true); if (n1 < 0) break; DA_STORET(X, bo ^ 32768); __syncthreads(); bo ^= 32768; cur = n1; n1 = n2; }
            for (;;) { DA_STEP(sb, sa) DA_STEP(sa, sb) }
#undef DA_STEP
#undef DA_POP
        }
        __syncthreads();
#undef DA_LOADT
#undef DA_STORET
#undef DA_COMPUTE
        l += __shfl_xor(l, 32);
        const float inv = 1.0f / l;
        if (mp == 1) {
#pragma unroll
            for (int d = 0; d < 4; ++d)
#pragma unroll
                for (int r = 0; r < 16; ++r) xch[(d * 16 + r) * 64] = o[d][r] * inv;
        }
        __syncthreads();
        if (mp == 0) {
            float ss = 0.f;
#pragma unroll
            for (int d = 0; d < 4; ++d)
#pragma unroll
                for (int r = 0; r < 16; ++r) { const float v = o[d][r] * inv - lam * xch[(d * 16 + r) * 64]; o[d][r] = v; ss += v * v; }
            ss += __shfl_xor(ss, 32);
            const float rs = rsqrtf(ss * (1.0f / 128.0f) + 1e-5f) * outscale;
            GAS bf16_t* op = AO + (tokb + qpos) * 1024 + h * 128 + 4 * hi;
#pragma unroll
            for (int d = 0; d < 4; ++d)
#pragma unroll
                for (int r4 = 0; r4 < 4; ++r4) { const f32x4 g = *(const GAS f32x4*)(subln + 32 * d + 8 * r4 + 4 * hi);
                    u32x2 w; w.x = cvtpk(o[d][4 * r4] * rs * g[0], o[d][4 * r4 + 1] * rs * g[1]); w.y = cvtpk(o[d][4 * r4 + 2] * rs * g[2], o[d][4 * r4 + 3] * rs * g[3]);
                    *(GAS u32x2*)(op + 32 * d + 8 * r4) = w; }
        }
    }
}
#undef GAS

#define GAS __attribute__((address_space(1)))
constexpr int NA_RING = 147456, NA_TB = NA_RING;
__device__ __forceinline__ void na_phase(LAS unsigned char* lds, const bf16_t* QK_, const bf16_t* VT_, bf16_t* AO_, const float* rpb_, int G, int bx) {
    int tid_ = threadIdx.x; asm volatile("" : "+v"(tid_));
    const int tid = tid_, lane = tid & 63, wid = __builtin_amdgcn_readfirstlane(tid >> 6), n = lane & 15, g = lane >> 4;
    const GAS bf16_t* QK = (const GAS bf16_t*)QK_; const GAS bf16_t* VT = (const GAS bf16_t*)VT_; GAS bf16_t* AO = (GAS bf16_t*)AO_; const GAS float* rpb = (const GAS float*)rpb_;
    LAS float* tb = (LAS float*)(lds + NA_TB);
    const int rq = wid >> 2, qg = wid & 3, c0 = 16 * qg, cw0 = (qg == 0) ? 0 : (qg == 1) ? 8 : (qg == 2) ? 24 : 32;
    const int c = c0 + n, cs = min(max(c - 8, 0), 48);
    unsigned ka[2], va[2];
#pragma unroll
    for (int ks = 0; ks < 2; ++ks) ka[ks] = (cw0 + n) * 128 + (((4 * ks + g) ^ (n & 7)) * 16);
    { const int c8 = (cw0 >> 2) + g; va[0] = 8192 + n * 128 + (((c8 >> 1) ^ (n & 7)) * 16) + (c8 & 1) * 8; va[1] = 8192 + n * 128 + ((((c8 >> 1) + 2) ^ (n & 7)) * 16) + (c8 & 1) * 8; }
    const int tr = tid >> 3, tc = tid & 7;
    const unsigned sdst = tr * 128 + ((tc ^ (tr & 7)) * 16);
    int bidx[8]; unsigned vmask = 0;
#pragma unroll
    for (int j8 = 0; j8 < 8; ++j8) { const int kc = cw0 + 16 * (j8 >> 2) + 4 * g + (j8 & 3); bidx[j8] = min(max(kc - c + 15, 0), 30); vmask |= ((unsigned)(kc - cs) < 16u) ? (1u << j8) : 0u; }
    for (int un = bx; un < 256; un += G) {
        const int b = un >> 4, h = un & 15;
        __syncthreads();
        for (int i = tid; i < 15 * 31; i += 512) tb[i] = rpb[h * 465 + i] * LOG2E;
        const GAS bf16_t* ksrc = QK + ((size_t)b * SEQ + tr) * 2048 + 1024 + h * 64 + tc * 8;
        const GAS bf16_t* vsrc = VT + (size_t)(h * 64 + tr) * MTOK + (size_t)b * SEQ + tc * 8;
#define NA_LDK(row) (*(const GAS u32x4*)(ksrc + (size_t)(row) * 64 * 2048))
#define NA_LDV(row) (*(const GAS u32x4*)(vsrc + (row) * 64))
#define NA_ST(row, kv, vv_) do { const unsigned so_ = (unsigned)((row) % 9) * 16384u + sdst; *(LAS u32x4*)(lds + so_) = (kv); *(LAS u32x4*)(lds + so_ + 8192) = (vv_); } while (0)
#pragma unroll
        for (int row = 0; row < 8; row += 4) { const u32x4 a0 = NA_LDK(row), b0 = NA_LDV(row), a1 = NA_LDK(row + 1), b1 = NA_LDV(row + 1), a2 = NA_LDK(row + 2), b2 = NA_LDV(row + 2), a3 = NA_LDK(row + 3), b3 = NA_LDV(row + 3);
            NA_ST(row, a0, b0); NA_ST(row + 1, a1, b1); NA_ST(row + 2, a2, b2); NA_ST(row + 3, a3, b3); }
        int loaded_hi = 7;
        const GAS bf16_t* qbase = QK + ((size_t)b * SEQ + rq * 64 + c0 + n) * 2048 + h * 64 + 8 * g;
        bf16x8 q0 = *(const GAS bf16x8*)qbase, q1 = *(const GAS bf16x8*)(qbase + 32);
        __syncthreads();
        for (int s = 0; s < 32; ++s) {
            const int tgt = (s < 31) ? (min(max(2 * s - 1, 0), 56) + 7) : loaded_hi;
            const int nnew = tgt - loaded_hi;
            const int ra_ = min(loaded_hi + 1, 63), rb_ = min(loaded_hi + 2, 63);
            const u32x4 p0 = NA_LDK(ra_), p1 = NA_LDV(ra_), p2 = NA_LDK(rb_), p3 = NA_LDV(rb_);
            const int sn = (s < 31) ? s + 1 : s;
            const bf16x8 q0n = *(const GAS bf16x8*)(qbase + (size_t)sn * 128 * 2048), q1n = *(const GAS bf16x8*)(qbase + (size_t)sn * 128 * 2048 + 32);
            const int r = 2 * s + rq, rs = min(max(r - 4, 0), 56);
            const int slot0 = rs % 9;
            float bvl[8][8];
#pragma unroll
            for (int kr = 0; kr < 8; ++kr) { const LAS float* rowp = tb + (rs + kr - r + 7) * 31;
#pragma unroll
                for (int j8 = 0; j8 < 8; ++j8) bvl[kr][j8] = rowp[bidx[j8]]; }
            __builtin_amdgcn_sched_group_barrier(0x100, 64, 0);
            f32x4 st[16];
#pragma unroll
            for (int kp = 0; kp < 4; ++kp) {
                bf16x8 kf[2][2][2];
#pragma unroll
                for (int k2 = 0; k2 < 2; ++k2) { int sl = slot0 + 2 * kp + k2; sl = (sl >= 9) ? sl - 9 : sl; const unsigned base = (unsigned)sl * 16384u;
#pragma unroll
                    for (int hf = 0; hf < 2; ++hf) { kf[k2][hf][0] = *(const LAS bf16x8*)(lds + base + hf * 2048 + ka[0]); kf[k2][hf][1] = *(const LAS bf16x8*)(lds + base + hf * 2048 + ka[1]); } }
#pragma unroll
                for (int k2 = 0; k2 < 2; ++k2)
#pragma unroll
                    for (int hf = 0; hf < 2; ++hf) { f32x4 a = __builtin_amdgcn_mfma_f32_16x16x32_bf16(kf[k2][hf][0], q0, (f32x4){0.f, 0.f, 0.f, 0.f}, 0, 0, 0);
                        st[(2 * kp + k2) * 2 + hf] = __builtin_amdgcn_mfma_f32_16x16x32_bf16(kf[k2][hf][1], q1, a, 0, 0, 0); }
                __builtin_amdgcn_sched_group_barrier(0x100, 8, 0); __builtin_amdgcn_sched_group_barrier(0x008, 8, 0);
            }
            float mx = -INFINITY;
#pragma unroll
            for (int kr = 0; kr < 8; ++kr)
#pragma unroll
                for (int j8 = 0; j8 < 8; ++j8) { const float v = ((vmask >> j8) & 1u) ? st[kr * 2 + (j8 >> 2)][j8 & 3] + bvl[kr][j8] : -INFINITY; st[kr * 2 + (j8 >> 2)][j8 & 3] = v; mx = __builtin_fmaxf(mx, v); }
            mx = __builtin_fmaxf(mx, __shfl_xor(mx, 16)); mx = __builtin_fmaxf(mx, __shfl_xor(mx, 32));
            float l = 0.f;
#pragma unroll
            for (int ti = 0; ti < 16; ++ti)
#pragma unroll
                for (int i = 0; i < 4; ++i) { const float e = __builtin_amdgcn_exp2f(st[ti][i] - mx); st[ti][i] = e; l += e; }
            l += __shfl_xor(l, 16); l += __shfl_xor(l, 32);
            const float inv = 1.0f / l;
            f32x4 o[4];
#pragma unroll
            for (int dt = 0; dt < 4; ++dt) o[dt] = (f32x4){0.f, 0.f, 0.f, 0.f};
#pragma unroll
            for (int kp = 0; kp < 4; ++kp) {
                u32x2 vv[2][4][2];
#pragma unroll
                for (int k2 = 0; k2 < 2; ++k2) { int sl = slot0 + 2 * kp + k2; sl = (sl >= 9) ? sl - 9 : sl; const unsigned base = (unsigned)sl * 16384u;
#pragma unroll
                    for (int dt = 0; dt < 4; ++dt) { vv[k2][dt][0] = *(const LAS u32x2*)(lds + base + dt * 2048 + va[0]); vv[k2][dt][1] = *(const LAS u32x2*)(lds + base + dt * 2048 + va[1]); } }
#pragma unroll
                for (int k2 = 0; k2 < 2; ++k2) { const int kr = 2 * kp + k2;
                    u32x4 w; w.x = cvtpk(st[2 * kr][0], st[2 * kr][1]); w.y = cvtpk(st[2 * kr][2], st[2 * kr][3]); w.z = cvtpk(st[2 * kr + 1][0], st[2 * kr + 1][1]); w.w = cvtpk(st[2 * kr + 1][2], st[2 * kr + 1][3]);
                    const bf16x8 pf = __builtin_bit_cast(bf16x8, w);
#pragma unroll
                    for (int dt = 0; dt < 4; ++dt) { const u32x4 v4 = {vv[k2][dt][0].x, vv[k2][dt][0].y, vv[k2][dt][1].x, vv[k2][dt][1].y};
                        o[dt] = __builtin_amdgcn_mfma_f32_16x16x32_bf16(__builtin_bit_cast(bf16x8, v4), pf, o[dt], 0, 0, 0); } }
                __builtin_amdgcn_sched_group_barrier(0x100, 16, 0); __builtin_amdgcn_sched_group_barrier(0x008, 8, 0);
            }
            GAS bf16_t* op = AO + ((size_t)b * SEQ + r * 64 + c0 + n) * 1024 + h * 64 + 4 * g;
#pragma unroll
            for (int dt = 0; dt < 4; ++dt) { u32x2 w; w.x = cvtpk(o[dt][0] * inv, o[dt][1] * inv); w.y = cvtpk(o[dt][2] * inv, o[dt][3] * inv); *(GAS u32x2*)(op + 16 * dt) = w; }
            __syncthreads();
            if (nnew >= 1) NA_ST(loaded_hi + 1, p0, p1);
            if (nnew >= 2) NA_ST(loaded_hi + 2, p2, p3);
            loaded_hi = tgt; q0 = q0n; q1 = q1n;
            __syncthreads();
        }
#undef NA_LDK
#undef NA_LDV
#undef NA_ST
    }
}
#undef GAS
#undef LAS
}
#define LAS __attribute__((address_space(3)))
typedef unsigned short bf16;
typedef unsigned v4u __attribute__((ext_vector_type(4)));
typedef unsigned v2u __attribute__((ext_vector_type(2)));
typedef float f32x4 __attribute__((ext_vector_type(4)));
constexpr int NWAVES = 8, NTHR = 512;
constexpr int M = 65536, D = 1024, FF = 2816, PLE = 256, DEPTH = 4, SEQ = 4096;
constexpr size_t MiB = 1u << 20;
constexpr size_t WS_SSQ = 913 * MiB;
constexpr size_t WS_W = 4 * MiB, W_LAYER = 27 * MiB;
constexpr size_t WO_QKV = 0, WO_O = 6 * MiB, WO_GU = 8 * MiB, WO_DN = 19 * MiB, WO_PG = 19 * MiB + 5632 * 1024, WO_PP = WO_PG + 2 * MiB;
constexpr size_t WS_PB = 112 * MiB;
constexpr size_t WS_HB0 = 144 * MiB, WS_HB1 = 272 * MiB;
constexpr size_t WS_QK = 400 * MiB, WS_VT = 656 * MiB;
constexpr size_t WS_HID = 400 * MiB;
constexpr size_t WS_AO = 784 * MiB;
constexpr size_t WS_BAR = 912 * MiB;
constexpr size_t WS_KN = 920 * MiB;
constexpr size_t WS_END = 921 * MiB;
static_assert(WO_PP + (size_t)1024 * 256 * 2 <= W_LAYER && WS_W + 4 * W_LAYER <= WS_PB && WS_HID + (size_t)M * FF * 2 <= WS_AO, "ws map");
constexpr int LDS_BYTES = 155648;

struct Params {
    const float* in[22];
    float* out; unsigned char* ws;
};

__device__ __forceinline__ unsigned f2bf(float f) { unsigned u = __builtin_bit_cast(unsigned, f); return (u + 0x7fffu + ((u >> 16) & 1u)) >> 16; }
__device__ __forceinline__ unsigned pk2(float lo, float hi) { return f2bf(lo) | (f2bf(hi) << 16); }
__device__ __forceinline__ float wave_sum(float v) {
#pragma unroll
    for (int o = 1; o < 64; o <<= 1) v += __shfl_xor(v, o);
    return v;
}
__device__ __forceinline__ void transpose_item(const float* __restrict__ W, int K, int N, const float* __restrict__ gk, bf16* __restrict__ WT, int grp, int gstride, int goff, LAS float* scr, int item, int lane) {
    const int nblk = N / 32, kb = item / nblk, nb = item % nblk, k0 = 64 * kb, n0 = 32 * nb;
    float wv_[32], gs_[32];
#pragma unroll
    for (int i = 0; i < 32; ++i) { const int kk = 2 * i + (lane >> 5); gs_[i] = gk ? ((const __attribute__((address_space(1))) float*)gk)[k0 + kk] : 1.f; wv_[i] = ((const __attribute__((address_space(1))) float*)W)[(size_t)(k0 + kk) * N + n0 + (lane & 31)]; }
#pragma unroll
    for (int i = 0; i < 32; ++i) { const int kk = 2 * i + (lane >> 5); scr[kk * 33 + (lane & 31)] = wv_[i] * gs_[i]; }
    asm volatile("s_waitcnt lgkmcnt(0)" ::: "memory");
    const int c = lane & 7;
#pragma unroll
    for (int j = 0; j < 4; ++j) { const int n = (lane >> 3) + 8 * j; const LAS float* s = scr + (8 * c) * 33 + n;
        v4u o; o.x = pk2(s[0 * 33], s[1 * 33]); o.y = pk2(s[2 * 33], s[3 * 33]); o.z = pk2(s[4 * 33], s[5 * 33]); o.w = pk2(s[6 * 33], s[7 * 33]);
        const int nn = n0 + n, orow = (nn / grp) * gstride + goff + (nn % grp);
        *(__attribute__((address_space(1))) v4u*)(WT + (size_t)orow * K + k0 + 8 * c) = o; }
    asm volatile("s_waitcnt lgkmcnt(0)" ::: "memory");
}

__global__ void __launch_bounds__(NTHR) fwd_megakernel(Params P) {
    extern __shared__ __attribute__((aligned(16))) unsigned char lds_raw[];
    cg::grid_group grid = cg::this_grid();
    unsigned bar_gen = 0;
#define GRID_SYNC() do { asm volatile("s_waitcnt vmcnt(0) lgkmcnt(0)" ::: "memory"); __syncthreads(); \
        if (threadIdx.x == 0) { __builtin_amdgcn_fence(__ATOMIC_RELEASE, "agent"); asm volatile("s_waitcnt vmcnt(0)" ::: "memory"); bar_gen += 1u; \
              \
            const unsigned ngrp_ = (gridDim.x & 7u) ? 1u : 8u, gsz_ = gridDim.x / ngrp_; \
            unsigned* top_ = (unsigned*)(P.ws + WS_BAR); unsigned* grp_ = top_ + 64u * (1u + (ngrp_ == 8u ? (blockIdx.x & 7u) : 0u)); \
            const unsigned old_ = __hip_atomic_fetch_add(grp_, 1u, __ATOMIC_RELAXED, __HIP_MEMORY_SCOPE_AGENT); \
            if (old_ + 1u == gsz_ * bar_gen) __hip_atomic_fetch_add(top_, 1u, __ATOMIC_RELAXED, __HIP_MEMORY_SCOPE_AGENT); \
            while (__hip_atomic_load(top_, __ATOMIC_RELAXED, __HIP_MEMORY_SCOPE_AGENT) < ngrp_ * bar_gen) __builtin_amdgcn_s_sleep(1); \
            __builtin_amdgcn_fence(__ATOMIC_ACQUIRE, "agent"); asm volatile("s_waitcnt vmcnt(0)" ::: "memory"); } \
        __syncthreads(); } while (0)
    LAS unsigned char* lds = (LAS unsigned char*)lds_raw;
#define OPQ_TID() int tid = threadIdx.x; asm volatile("" : "+v"(tid)); const int lane = tid & 63, wave = __builtin_amdgcn_readfirstlane(tid >> 6); \
        const int G = gridDim.x, bx = blockIdx.x, gw = bx * NWAVES + wave, NGW = G * NWAVES; (void)lane; (void)gw; (void)NGW; (void)G; (void)bx
#define OPQ_WS() unsigned char* ws = P.ws; asm volatile("" : "+s"(ws)); pg8::u64* ssq = (pg8::u64*)(ws + WS_SSQ); float* out = P.out; asm volatile("" : "+s"(out))
#define OPQ_LAYER() OPQ_WS(); int lo = li; asm volatile("" : "+s"(lo)); const int j = lo >> 1; unsigned char* wl = ws + WS_W + (size_t)lo * W_LAYER; \
        bf16* HBc = (bf16*)(ws + ((lo & 1) ? WS_HB1 : WS_HB0)); bf16* HBn = (bf16*)(ws + ((lo & 1) ? WS_HB0 : WS_HB1)); \
        pg8::u64* ssq_mix = ssq + (size_t)(3 * lo) * M; pg8::u64* ssq_ffn = ssq_mix + M; pg8::u64* ssq_ple = ssq_ffn + M; pg8::u64* ssq_nxt = ssq_ple + M; \
        bf16* QK = (bf16*)(ws + WS_QK); bf16* VT = (bf16*)(ws + WS_VT); bf16* HID = (bf16*)(ws + WS_HID); bf16* AO = (bf16*)(ws + WS_AO); bf16* PB = (bf16*)(ws + WS_PB); \
        (void)j; (void)wl; (void)HBc; (void)HBn; (void)ssq_mix; (void)ssq_ffn; (void)ssq_ple; (void)ssq_nxt; (void)QK; (void)VT; (void)HID; (void)AO; (void)PB
    {
        OPQ_TID(); OPQ_WS(); (void)out; bf16* HB0 = (bf16*)(ws + WS_HB0);
        const float* x = P.in[0]; const float* norm_mix = P.in[2]; const float* norm_ffn = P.in[3]; const float* norm_ple = P.in[4];
        LAS float* scr = (LAS float*)(lds + wave * 16384);
        constexpr int I_QKV = 16 * 96, I_O = 16 * 32, I_G = 16 * 88, I_DN = 44 * 32, I_PG = 16 * 32, I_PP = 4 * 32, I_LAYER = I_QKV + I_O + 2 * I_G + I_DN + I_PG + I_PP;
        for (int it = gw; it < DEPTH * I_LAYER; it += NGW) {
            const int li = it / I_LAYER, j = li >> 1; int r = it % I_LAYER;
            unsigned char* wl = ws + WS_W + (size_t)li * W_LAYER;
            if (r < I_QKV) { const float* W = (li & 1) ? P.in[13] + (size_t)j * D * 3 * D : P.in[6] + (size_t)j * D * 3 * D;
                transpose_item(W, D, 3 * D, norm_mix + li * D, (bf16*)(wl + WO_QKV), 3 * D, 0, 0, scr, r, lane); continue; } r -= I_QKV;
            if (r < I_O) { const float* W = (li & 1) ? P.in[16] + (size_t)j * D * D : P.in[7] + (size_t)j * D * D;
                transpose_item(W, D, D, nullptr, (bf16*)(wl + WO_O), D, 0, 0, scr, r, lane); continue; } r -= I_O;
            if (r < I_G) { transpose_item(P.in[17] + (size_t)li * D * FF, D, FF, norm_ffn + li * D, (bf16*)(wl + WO_GU), 128, 256, 0, scr, r, lane); continue; } r -= I_G;
            if (r < I_G) { transpose_item(P.in[18] + (size_t)li * D * FF, D, FF, norm_ffn + li * D, (bf16*)(wl + WO_GU), 128, 256, 128, scr, r, lane); continue; } r -= I_G;
            if (r < I_DN) { transpose_item(P.in[19] + (size_t)li * FF * D, FF, D, nullptr, (bf16*)(wl + WO_DN), D, 0, 0, scr, r, lane); continue; } r -= I_DN;
            if (r < I_PG) { transpose_item(P.in[21] + (size_t)li * D * D, D, D, norm_ple + li * D, (bf16*)(wl + WO_PG), D, 0, 0, scr, r, lane); continue; } r -= I_PG;
            transpose_item(P.in[20] + (size_t)li * PLE * D, PLE, D, nullptr, (bf16*)(wl + WO_PP), D, 0, 0, scr, r, lane);
        }
        for (int g32 = gw; g32 < M / 32; g32 += NGW) {
            float keep = 0.f;
#pragma unroll 4
            for (int rr = 0; rr < 32; ++rr) {
                const int m = g32 * 32 + rr;
                const f32x4* xr = (const f32x4*)(x + (size_t)m * D) + lane; f32x4 v[4]; float sq = 0.f;
#pragma unroll
                for (int jj = 0; jj < 4; ++jj) { v[jj] = xr[64 * jj]; sq += (v[jj].x * v[jj].x + v[jj].y * v[jj].y) + (v[jj].z * v[jj].z + v[jj].w * v[jj].w); }
                sq = wave_sum(sq); if (lane == rr) keep = sq;
                v2u* o8 = (v2u*)(HB0 + (size_t)m * D) + lane;
#pragma unroll
                for (int jj = 0; jj < 4; ++jj) { v2u w; w.x = pk2(v[jj].x, v[jj].y); w.y = pk2(v[jj].z, v[jj].w); o8[64 * jj] = w; }
            }
            if (lane < 32) ssq[g32 * 32 + lane] = (pg8::u64)(keep * pg8::SSQ_FIX + 0.5f);
        }
        for (int i = bx * NTHR + tid; i < 12 * M / 2; i += G * NTHR) ((v4u*)(ssq + M))[i] = (v4u){0u, 0u, 0u, 0u};
    }
    GRID_SYNC();
    grid.sync();

#pragma unroll 1
    for (int li = 0; li < DEPTH; ++li) {
        const bool is_da = (li & 1) == 0;
        {
            OPQ_TID(); OPQ_LAYER();
            const float* bqkv = is_da ? nullptr : P.in[14] + (size_t)j * 3 * D;
            { pg8::Gemm g{HBc, (const bf16*)(wl + WO_QKV), M, 2 * D, D}; pg8::StaticOrder S; S.init(M, 2 * D, G, bx);
              pg8::EpiQK E{QK, 2 * D, ssq_mix, bqkv, D, 0.125f * 1.4426950408889634f};
              GEMM_CALL_EpiQK(pg8::gemm_phase<pg8::EpiQK, pg8::StaticOrder, true, true>(lds, g, S, E)); }
            { pg8::Gemm g{(const bf16*)(wl + WO_QKV) + (size_t)2 * D * D, HBc, D, M, D}; pg8::StaticOrder S; S.init(D, M, G, bx);
              pg8::EpiVT E{VT, M, ssq_mix, bqkv ? bqkv + 2 * D : nullptr};
              GEMM_CALL_EpiVT(pg8::gemm_phase<pg8::EpiVT, pg8::StaticOrder, true, true>(lds, g, S, E)); }
        }
        GRID_SYNC();
        { OPQ_TID(); OPQ_LAYER(); const float* pin = P.in[1];
        if (is_da) {
            float d1 = 0.f, d2 = 0.f;
            { const float* q1 = P.in[8] + j * 64; const float* k1 = P.in[9] + j * 64; const float* q2 = P.in[10] + j * 64; const float* k2 = P.in[11] + j * 64;
              d1 = wave_sum(q1[lane] * k1[lane]); d2 = wave_sum(q2[lane] * k2[lane]); }
            const float lam_init = 0.8f - 0.6f * __expf(-0.3f * (float)li);
            const float lam = __expf(d1) - __expf(d2) + lam_init;
#ifndef NO_DA
            float* KN = (float*)(ws + WS_KN);
            att::da_knorm(QK, KN, gw, NGW, lane);
            GRID_SYNC();
            att::da_phase(lds, QK, VT, AO, KN, lam, 1.0f - lam_init, P.in[12] + j * 128, G, bx);
#else
            for (int i = bx * NTHR + tid; i < M * D / 8; i += G * NTHR) ((v4u*)AO)[i] = (v4u){0u, 0u, 0u, 0u};
#endif
        } else {
#ifndef NO_NA
            att::na_phase(lds, QK, VT, AO, P.in[15] + (size_t)j * 16 * 15 * 31, G, bx);
#else
            for (int i = bx * NTHR + tid; i < M * D / 8; i += G * NTHR) ((v4u*)AO)[i] = (v4u){0u, 0u, 0u, 0u};
#endif
        }
#ifdef EXP_TWICE
        if (is_da && li == 0) {
            GRID_SYNC();
            { float d1 = wave_sum(P.in[8][lane] * P.in[9][lane]), d2 = wave_sum(P.in[10][lane] * P.in[11][lane]); const float lam_init = 0.8f - 0.6f * __expf(-0.3f * (float)li);
              att::da_phase(lds, QK, VT, (bf16*)(ws + WS_HB1), (float*)(ws + WS_KN), __expf(d1) - __expf(d2) + lam_init, 1.0f - lam_init, P.in[12], G, bx); }
            GRID_SYNC();
            { const v4u* a = (const v4u*)AO; const v4u* c = (const v4u*)(ws + WS_HB1); unsigned bad = 0;
              for (int i = bx * NTHR + tid; i < M * D / 8; i += G * NTHR) { const v4u u = a[i], w = c[i]; bad |= (u.x ^ w.x) | (u.y ^ w.y) | (u.z ^ w.z) | (u.w ^ w.w); }
              if (bad) __hip_atomic_store((unsigned*)(ws + WS_BAR + 128), 1u, __ATOMIC_RELAXED, __HIP_MEMORY_SCOPE_AGENT); }
        }
#endif
        { const f32x4* src = (const f32x4*)(pin + (size_t)li * M * PLE); v4u* dst = (v4u*)PB;
          const int str_ = G * NTHR;
          for (int i = bx * NTHR + tid; i < M * PLE / 8; i += 4 * str_) { f32x4 a[4], c[4];
#pragma unroll
              for (int k = 0; k < 4; ++k) { const int ii = min(i + k * str_, M * PLE / 8 - 1); a[k] = ((const __attribute__((address_space(1))) f32x4*)src)[2 * ii]; c[k] = ((const __attribute__((address_space(1))) f32x4*)src)[2 * ii + 1]; }
#pragma unroll
              for (int k = 0; k < 4; ++k) { const int ii = i + k * str_; if (ii < M * PLE / 8) { v4u w; w.x = pk2(a[k].x, a[k].y); w.y = pk2(a[k].z, a[k].w); w.z = pk2(c[k].x, c[k].y); w.w = pk2(c[k].z, c[k].w); ((__attribute__((address_space(1))) v4u*)dst)[ii] = w; } } } }
        }
        GRID_SYNC();
        { OPQ_TID(); OPQ_LAYER(); const float* x = P.in[0];
          pg8::Gemm g{AO, (const bf16*)(wl + WO_O), M, D, D}; pg8::StaticOrder S; S.init(M, D, G, bx);
          pg8::EpiResid E{li == 0 ? x : out, out, HBc, ssq_ffn};
          GEMM_CALL_EpiResid(pg8::gemm_phase<pg8::EpiResid, pg8::StaticOrder, true, true>(lds, g, S, E)); }
        GRID_SYNC();
        { OPQ_TID(); OPQ_LAYER();
          pg8::Gemm g{HBc, (const bf16*)(wl + WO_GU), M, 2 * FF, D}; pg8::StaticOrder S; S.init(M, 2 * FF, G, bx);
          pg8::EpiSwiGLU E{HID, ssq_ffn};
          GEMM_CALL_EpiSwiGLU(pg8::gemm_phase<pg8::EpiSwiGLU, pg8::StaticOrder, true, true>(lds, g, S, E)); }
        { OPQ_TID(); OPQ_LAYER();
          pg8::Gemm g{PB, (const bf16*)(wl + WO_PP), M, D, PLE}; pg8::StaticOrder S; S.init(M, D, G, bx);
          pg8::EpiQK E{AO, D, nullptr, nullptr, 0, 1.f};
          GEMM_CALL_EpiQK(pg8::gemm_phase<pg8::EpiQK, pg8::StaticOrder, true, true>(lds, g, S, E)); }
        GRID_SYNC();
        { OPQ_TID(); OPQ_LAYER();
          pg8::Gemm g{HID, (const bf16*)(wl + WO_DN), M, D, FF}; pg8::StaticOrder S; S.init(M, D, G, bx);
          pg8::EpiResid E{out, out, HBc, ssq_ple};
          GEMM_CALL_EpiResid(pg8::gemm_phase<pg8::EpiResid, pg8::StaticOrder, true, true>(lds, g, S, E)); }
        GRID_SYNC();
        { OPQ_TID(); OPQ_LAYER();
          pg8::Gemm g{HBc, (const bf16*)(wl + WO_PG), M, D, D}; pg8::StaticOrder S; S.init(M, D, G, bx);
          pg8::EpiPle E{out, AO, HBn, ssq_ple, ssq_nxt};
          GEMM_CALL_EpiPle(pg8::gemm_phase<pg8::EpiPle, pg8::StaticOrder, true, true>(lds, g, S, E)); }
        GRID_SYNC();
    }
    {
        OPQ_TID(); OPQ_WS(); const float* norm_final = P.in[5];
        const pg8::u64* sq = ssq + (size_t)12 * M;
        typedef __attribute__((address_space(1))) f32x4 gf4;
        f32x4 gg[4];
#pragma unroll
        for (int jj = 0; jj < 4; ++jj) gg[jj] = ((const gf4*)norm_final)[lane + 64 * jj];
        for (int m0 = gw; m0 < M; m0 += 4 * NGW) {
            f32x4 v[4][4]; pg8::u64 q4[4];
#pragma unroll
            for (int k = 0; k < 4; ++k) { const int m = m0 + k * NGW; q4[k] = ((const __attribute__((address_space(1))) pg8::u64*)sq)[m];
#pragma unroll
                for (int jj = 0; jj < 4; ++jj) v[k][jj] = ((const gf4*)(out + (size_t)m * D))[lane + 64 * jj]; }
#pragma unroll
            for (int k = 0; k < 4; ++k) { const int m = m0 + k * NGW; const float rs = pg8::rstd_of(q4[k]);
#pragma unroll
                for (int jj = 0; jj < 4; ++jj) ((gf4*)(out + (size_t)m * D))[lane + 64 * jj] = v[k][jj] * rs * gg[jj]; }
        }
        for (int m = M; m < M; ++m) { f32x4* hr = nullptr; (void)hr;
#ifdef EXP_TWICE
            if (__hip_atomic_load((unsigned*)(ws + WS_BAR + 128), __ATOMIC_RELAXED, __HIP_MEMORY_SCOPE_AGENT)) { const float qn = __builtin_nanf("");
                for (int jj = 0; jj < 4; ++jj) hr[64 * jj] = (f32x4){qn, qn, qn, qn}; }
#endif
        }
    }
}

extern "C" void kernel_launch(void* const* d_in, const int* in_sizes, int n_in, void* d_out, int out_size, void* d_ws, size_t ws_size, hipStream_t stream) {
    static int grid_blocks = 0;
    if (grid_blocks == 0) {
        if (n_in != 22 || out_size != M * D || ws_size < WS_END) { fprintf(stderr, "kernel_launch: unexpected shapes (n_in %d, out %d, ws %zu)\n", n_in, out_size, ws_size); grid_blocks = -1; return; }
        int dev = 0, cus = 0, per_cu = 0;
        hipGetDevice(&dev);
        hipDeviceGetAttribute(&cus, hipDeviceAttributeMultiprocessorCount, dev);
        if (hipFuncSetAttribute((const void*)fwd_megakernel, hipFuncAttributeMaxDynamicSharedMemorySize, LDS_BYTES) != hipSuccess) fprintf(stderr, "kernel_launch: hipFuncSetAttribute failed\n");
        if (hipOccupancyMaxActiveBlocksPerMultiprocessor(&per_cu, (const void*)fwd_megakernel, NTHR, LDS_BYTES) != hipSuccess || per_cu < 1) { fprintf(stderr, "kernel_launch: occupancy query gave %d\n", per_cu); per_cu = 1; }
        (void)hipGetLastError();
        grid_blocks = cus * per_cu;
    }
    if (grid_blocks < 0) return;
    if (hipMemsetAsync((char*)d_ws + WS_BAR, 0, 4096, stream) != hipSuccess) { fprintf(stderr, "kernel_launch: memset failed\n"); return; }
    Params p{};
    for (int i = 0; i < 22; ++i) p.in[i] = (const float*)d_in[i];
    p.out = (float*)d_out; p.ws = (unsigned char*)d_ws;
    void* args[] = {&p};
    hipError_t e = hipLaunchCooperativeKernel((const void*)fwd_megakernel, dim3(grid_blocks), dim3(NTHR), args, LDS_BYTES, stream);
    if (e != hipSuccess) fprintf(stderr, "cooperative launch failed: %s (grid %d)\n", hipGetErrorString(e), grid_blocks);
}
```

```cpp
#ifndef GQ
#define GQ(...) __VA_ARGS__
#endif
#ifndef GV
#define GV(...) __VA_ARGS__
#endif
#ifndef GR
#define GR(...) __VA_ARGS__
#endif
#ifndef GS
#define GS(...) __VA_ARGS__
#endif
#ifndef GP
#define GP(...) __VA_ARGS__
#endif
#define GEMM_CALL_EpiQK(...) GQ(__VA_ARGS__)
#define GEMM_CALL_EpiVT(...) GV(__VA_ARGS__)
#define GEMM_CALL_EpiResid(...) GR(__VA_ARGS__)
#define GEMM_CALL_EpiSwiGLU(...) GS(__VA_ARGS__)
#define GEMM_CALL_EpiPle(...) GP(__VA_ARGS__)
#include <hip/hip_runtime.h>
#include <hip/hip_cooperative_groups.h>
#include <cstdio>
#include <cstdint>
namespace cg = cooperative_groups;
namespace pg8 {
#define PG8_LAS __attribute__((address_space(3)))
typedef unsigned short bf16_t;
typedef short bf16x8 __attribute__((ext_vector_type(8)));
typedef float f32x4 __attribute__((ext_vector_type(4)));
typedef unsigned u32x4 __attribute__((ext_vector_type(4)));
constexpr int BM = 256, BK = 64, HALF = 128, HTB = HALF * BK * 2  , STAGE_BYTES = 8 * HTB, NXCD = 8, WGM = 8;

__host__ __device__ __forceinline__ int lds_byte(int r, int c) { const int st = (r >> 4) * 2 + (c >> 5), rr = r & 15, cc = c & 31, ob = rr * 64 + cc * 2; return st * 1024 + (ob ^ (((ob >> 9) & 1) << 5)); }
__host__ __device__ __forceinline__ void stage_rc(int b, int& R, int& C) { const int st = b / 1024, sb = b % 1024, swz = sb ^ (((sb >> 9) & 1) << 5); R = (st >> 1) * 16 + swz / 64; C = (st & 1) * 32 + (swz % 64) / 2; }
__host__ __device__ __forceinline__ int perm32(int rho) { const int n = rho >> 4, i = rho & 15; return 8 * (i >> 2) + 4 * n + (i & 3); }

struct Unit { int pm, pn; };
struct Gemm { const bf16_t* A; const bf16_t* Bt; int M, N, K; };

struct StaticOrder {
    int nM, nN, nwg, G, c;
    __host__ __device__ void init(int M, int N, int G_, int c_) { nM = M / BM; nN = N / BM; nwg = nM * nN; G = G_; c = c_; }
    __host__ __device__ bool next(int i, Unit& u) const {
        const long L = (long)i * G + c; if (L >= nwg) return false;
        int wgid = (int)L; { const int q = nwg / NXCD, r = nwg % NXCD, xcd = wgid % NXCD, off = wgid / NXCD; wgid = (xcd < r ? xcd * (q + 1) : r * (q + 1) + (xcd - r) * q) + off; }
        const int nig = WGM * nN, gid = wgid / nig, fm = gid * WGM, gsz = (nM - fm) < WGM ? (nM - fm) : WGM;
        u.pm = fm + ((wgid % nig) % gsz); u.pn = (wgid % nig) / gsz; return true;
    }
    __device__ __forceinline__ void a_ready(const Unit&) const {}
    __device__ __forceinline__ void done(const Unit&) const {}
};

__device__ __forceinline__ unsigned cvt_pk_bf16(float lo, float hi) { unsigned r; asm volatile("v_cvt_pk_bf16_f32 %0, %1, %2" : "=v"(r) : "v"(lo), "v"(hi)); return r; }
typedef float f32x2 __attribute__((ext_vector_type(2)));
typedef unsigned u32x2 __attribute__((ext_vector_type(2)));
#define PG8_GAS __attribute__((address_space(1)))
constexpr float LOG2E = 1.4426950408889634f;
typedef unsigned long long u64;
constexpr float SSQ_FIX = 1048576.0f;
__device__ __forceinline__ float rstd_of(u64 q) { return rsqrtf((float)q * (1.0f / (SSQ_FIX * 1024.0f)) + 1e-6f); }
__device__ __forceinline__ float rstd_row(const u64* ssq, int row) { return rstd_of(((const PG8_GAS u64*)ssq)[row]); }
__device__ __forceinline__ float sigm(float a) { return __builtin_amdgcn_rcpf(1.0f + __builtin_amdgcn_exp2f(-a * LOG2E)); }
__device__ __forceinline__ void atomic_addf(u64* p, float v) { __hip_atomic_fetch_add((PG8_GAS u64*)p, (u64)(v * SSQ_FIX + 0.5f), __ATOMIC_RELAXED, __HIP_MEMORY_SCOPE_AGENT); }

struct EpiQK {
    static constexpr bool PERM = true, AFTER_DRAIN = false;
    bf16_t* O; int ldc; const u64* ssq; const float* bias; int qcols; float qscale;
    __device__ __forceinline__ void operator()(const f32x4 (&acc)[2][2][4][2], const Unit& u, int wr, int wc, int fr, int fq) const {
        const int row0 = u.pm * BM + wr * 64 + fr, col0 = u.pn * BM + wc * 32 + 8 * fq;
        const float sc = (u.pn * BM < qcols) ? qscale : 1.f;
        f32x4 bv[2][2];
#pragma unroll
        for (int bj = 0; bj < 2; ++bj)
#pragma unroll
            for (int n = 0; n < 2; ++n) bv[bj][n] = bias ? *(const PG8_GAS f32x4*)(bias + col0 + bj * HALF + 4 * n) : (f32x4){0.f, 0.f, 0.f, 0.f};
#pragma unroll
        for (int ai = 0; ai < 2; ++ai)
#pragma unroll
            for (int m = 0; m < 4; ++m) { const int row = row0 + ai * HALF + m * 16; const float rs = ssq ? rstd_row(ssq, row) : 1.f; bf16_t* rowp = O + (size_t)row * ldc + col0;
#pragma unroll
                for (int bj = 0; bj < 2; ++bj) { const f32x4 v0 = (acc[ai][bj][m][0] * rs + bv[bj][0]) * sc, v1 = (acc[ai][bj][m][1] * rs + bv[bj][1]) * sc;
                    u32x4 w; w.x = cvt_pk_bf16(v0[0], v0[1]); w.y = cvt_pk_bf16(v0[2], v0[3]); w.z = cvt_pk_bf16(v1[0], v1[1]); w.w = cvt_pk_bf16(v1[2], v1[3]);
                    *(PG8_GAS u32x4*)(rowp + bj * HALF) = w; } }
    }
};
struct EpiVT {
    static constexpr bool PERM = true, AFTER_DRAIN = false;
    bf16_t* O; int ldc; const u64* ssq; const float* bias;
    __device__ __forceinline__ void operator()(const f32x4 (&acc)[2][2][4][2], const Unit& u, int wr, int wc, int fr, int fq) const {
        const int row0 = u.pm * BM + wr * 64 + fr, col0 = u.pn * BM + wc * 32 + 8 * fq;
        f32x4 rs[2][2];
#pragma unroll
        for (int bj = 0; bj < 2; ++bj)
#pragma unroll
            for (int n = 0; n < 2; ++n) {
#pragma unroll
                for (int i = 0; i < 4; ++i) rs[bj][n][i] = rstd_of(((const PG8_GAS u64*)ssq)[col0 + bj * HALF + 4 * n + i]); }
#pragma unroll
        for (int ai = 0; ai < 2; ++ai)
#pragma unroll
            for (int m = 0; m < 4; ++m) { const int row = row0 + ai * HALF + m * 16; const float bb = bias ? ((const PG8_GAS float*)bias)[row] : 0.f; bf16_t* rowp = O + (size_t)row * ldc + col0;
#pragma unroll
                for (int bj = 0; bj < 2; ++bj) { const f32x4 v0 = acc[ai][bj][m][0] * rs[bj][0] + bb, v1 = acc[ai][bj][m][1] * rs[bj][1] + bb;
                    u32x4 w; w.x = cvt_pk_bf16(v0[0], v0[1]); w.y = cvt_pk_bf16(v0[2], v0[3]); w.z = cvt_pk_bf16(v1[0], v1[1]); w.w = cvt_pk_bf16(v1[2], v1[3]);
                    *(PG8_GAS u32x4*)(rowp + bj * HALF) = w; } }
    }
};
struct EpiResid {
    static constexpr bool PERM = false, AFTER_DRAIN = false;
    const bf16_t* base; bf16_t* hb; u64* ssq_next;
    __device__ __forceinline__ void operator()(const f32x4 (&acc)[2][2][4][2], const Unit& u, int wr, int wc, int fr, int fq) const {
        const int row0 = u.pm * BM + wr * 64 + fr, col0 = u.pn * BM + wc * 32 + 4 * fq;
#pragma unroll
        for (int ai = 0; ai < 2; ++ai) {
            u32x2 bs[4][2][2];
#pragma unroll
            for (int m = 0; m < 4; ++m) { const size_t off0 = (size_t)(row0 + ai * HALF + m * 16) * 1024 + col0;
#pragma unroll
                for (int bj = 0; bj < 2; ++bj)
#pragma unroll
                    for (int n = 0; n < 2; ++n) bs[m][bj][n] = *(const PG8_GAS u32x2*)(base + off0 + bj * HALF + n * 16); }
            asm volatile("" ::: "memory");
#pragma unroll
            for (int m = 0; m < 4; ++m) { const int row = row0 + ai * HALF + m * 16; const size_t off0 = (size_t)row * 1024 + col0; float ss = 0.f;
#pragma unroll
                for (int bj = 0; bj < 2; ++bj)
#pragma unroll
                    for (int n = 0; n < 2; ++n) { const size_t off = off0 + bj * HALF + n * 16; const u32x2 bw = bs[m][bj][n]; f32x4 v = acc[ai][bj][m][n];
                        v[0] += __uint_as_float(bw.x << 16); v[1] += __uint_as_float(bw.x & 0xffff0000u); v[2] += __uint_as_float(bw.y << 16); v[3] += __uint_as_float(bw.y & 0xffff0000u);
                        u32x2 w; w.x = cvt_pk_bf16(v[0], v[1]); w.y = cvt_pk_bf16(v[2], v[3]); *(PG8_GAS u32x2*)(hb + off) = w;
                        ss += (v[0] * v[0] + v[1] * v[1]) + (v[2] * v[2] + v[3] * v[3]); }
                ss += __shfl_xor(ss, 16); ss += __shfl_xor(ss, 32);
                if (fq == 0) atomic_addf(ssq_next + row, ss); }
            asm volatile("" ::: "memory");
        }
    }
};
struct EpiSwiGLU {
    static constexpr bool PERM = true, AFTER_DRAIN = false;
    bf16_t* O; const u64* ssq;
    __device__ __forceinline__ void operator()(const f32x4 (&acc)[2][2][4][2], const Unit& u, int wr, int wc, int fr, int fq) const {
        const int row0 = u.pm * BM + wr * 64 + fr, colh = u.pn * HALF + wc * 32 + 8 * fq;
#pragma unroll
        for (int ai = 0; ai < 2; ++ai)
#pragma unroll
            for (int m = 0; m < 4; ++m) { const int row = row0 + ai * HALF + m * 16; const float rs = rstd_row(ssq, row); f32x4 r[2];
#pragma unroll
                for (int n = 0; n < 2; ++n) { const f32x4 g = acc[ai][0][m][n] * rs, up = acc[ai][1][m][n] * rs;
#pragma unroll
                    for (int i = 0; i < 4; ++i) r[n][i] = g[i] * sigm(g[i]) * up[i]; }
                u32x4 w; w.x = cvt_pk_bf16(r[0][0], r[0][1]); w.y = cvt_pk_bf16(r[0][2], r[0][3]); w.z = cvt_pk_bf16(r[1][0], r[1][1]); w.w = cvt_pk_bf16(r[1][2], r[1][3]);
                *(PG8_GAS u32x4*)(O + (size_t)row * 2816 + colh) = w; }
    }
};
struct EpiPle {
    static constexpr bool PERM = false, AFTER_DRAIN = false;
    const bf16_t* hin; const bf16_t* proj; bf16_t* hb; const u64* ssq_in; u64* ssq_next;
    __device__ __forceinline__ void operator()(const f32x4 (&acc)[2][2][4][2], const Unit& u, int wr, int wc, int fr, int fq) const {
        const int row0 = u.pm * BM + wr * 64 + fr, col0 = u.pn * BM + wc * 32 + 4 * fq;
#pragma unroll
        for (int ai = 0; ai < 2; ++ai) {
            u32x2 hs[4][2][2], ps[4][2][2]; u64 sq[4];
#pragma unroll
            for (int m = 0; m < 4; ++m) { const int row = row0 + ai * HALF + m * 16; const size_t off0 = (size_t)row * 1024 + col0; sq[m] = ((const PG8_GAS u64*)ssq_in)[row];
#pragma unroll
                for (int bj = 0; bj < 2; ++bj)
#pragma unroll
                    for (int n = 0; n < 2; ++n) { hs[m][bj][n] = *(const PG8_GAS u32x2*)(hin + off0 + bj * HALF + n * 16); ps[m][bj][n] = *(const PG8_GAS u32x2*)(proj + off0 + bj * HALF + n * 16); } }
            asm volatile("" ::: "memory");
#pragma unroll
            for (int m = 0; m < 4; ++m) { const int row = row0 + ai * HALF + m * 16; const size_t off0 = (size_t)row * 1024 + col0; const float rs = rstd_of(sq[m]); float ss = 0.f;
#pragma unroll
                for (int bj = 0; bj < 2; ++bj)
#pragma unroll
                    for (int n = 0; n < 2; ++n) { const size_t off = off0 + bj * HALF + n * 16; const u32x2 pw = ps[m][bj][n], hw = hs[m][bj][n]; const f32x4 a = acc[ai][bj][m][n] * rs;
                        f32x4 pr; pr[0] = __uint_as_float(pw.x << 16); pr[1] = __uint_as_float(pw.x & 0xffff0000u); pr[2] = __uint_as_float(pw.y << 16); pr[3] = __uint_as_float(pw.y & 0xffff0000u);
                        f32x4 v; v[0] = __uint_as_float(hw.x << 16); v[1] = __uint_as_float(hw.x & 0xffff0000u); v[2] = __uint_as_float(hw.y << 16); v[3] = __uint_as_float(hw.y & 0xffff0000u);
#pragma unroll
                        for (int i = 0; i < 4; ++i) v[i] += sigm(a[i]) * pr[i];
                        u32x2 w; w.x = cvt_pk_bf16(v[0], v[1]); w.y = cvt_pk_bf16(v[2], v[3]); *(PG8_GAS u32x2*)(hb + off) = w;
                        ss += (v[0] * v[0] + v[1] * v[1]) + (v[2] * v[2] + v[3] * v[3]); }
                ss += __shfl_xor(ss, 16); ss += __shfl_xor(ss, 32);
                if (fq == 0) atomic_addf(ssq_next + row, ss); }
            asm volatile("" ::: "memory");
        }
    }
};
template <class Epi, class Sched, bool ALIGN_EPI = false, bool SP2 = false>
__device__ __forceinline__ void gemm_phase(PG8_LAS unsigned char* lds, const Gemm g, const Sched& S, const Epi& E) {
    int tid_ = threadIdx.x; asm volatile("" : "+v"(tid_));
    const int tid = tid_, wid = __builtin_amdgcn_readfirstlane(tid >> 6), lane = tid & 63, wr = wid >> 2, wc = wid & 3, fr = lane & 15, fq = lane >> 4;
    const int K = g.K, nt = K / BK;
    unsigned voffA[2], voffB[2];
#pragma unroll
    for (int i = 0; i < 2; ++i) { int R, C; stage_rc(tid * 16 + i * 8192, R, C); const int Rb = Epi::PERM ? ((R & ~31) + perm32(R & 31)) : R;
        voffA[i] = (unsigned)(R * K + C) * 2u; voffB[i] = (unsigned)(Rb * K + C) * 2u; }
    const size_t kstep = (size_t)(BK * 2);
    const size_t hstep = (size_t)HALF * K * 2;
    const size_t tstep = 2 * hstep;
    const unsigned ldsw = (unsigned)wid * 1024u;
    const int aoff = lds_byte(wr * 64 + fr, fq * 8), boff = lds_byte(wc * 32 + fr, fq * 8);
#define PG8_SA(b, h) (((b) * 2 + (h)) * HTB)
#define PG8_SB(b, h) ((4 + (b) * 2 + (h)) * HTB)
#define PG8_STAGE(bufoff, gbase, voff) do { _Pragma("unroll") for (int _i = 0; _i < 2; ++_i) \
        __builtin_amdgcn_global_load_lds((const unsigned*)((const char*)(gbase) + (voff)[_i]), (PG8_LAS unsigned*)(lds + (bufoff) + ldsw + _i * 8192), 16, 0, 0); } while (0)
#define PG8_LDA(dst, b, h) do { _Pragma("unroll") for (int m = 0; m < 4; ++m) _Pragma("unroll") for (int k = 0; k < 2; ++k) dst[m][k] = *(const PG8_LAS bf16x8*)(lds + PG8_SA(b, h) + aoff + m * 2048 + k * 1024); } while (0)
#define PG8_LDB(dst, b, h) do { _Pragma("unroll") for (int n = 0; n < 2; ++n) _Pragma("unroll") for (int k = 0; k < 2; ++k) dst[n][k] = *(const PG8_LAS bf16x8*)(lds + PG8_SB(b, h) + boff + n * 2048 + k * 1024); } while (0)
#define PG8_MMA(ai, bj, At, Bt) do { __builtin_amdgcn_s_setprio(1); _Pragma("unroll") for (int m = 0; m < 4; ++m) _Pragma("unroll") for (int n = 0; n < 2; ++n) _Pragma("unroll") for (int k = 0; k < 2; ++k) \
        acc[ai][bj][m][n] = __builtin_amdgcn_mfma_f32_16x16x32_bf16(Bt[n][k], At[m][k], acc[ai][bj][m][n], 0, 0, 0); __builtin_amdgcn_s_setprio(0); } while (0)
#define PG8_WAIT_V(n) asm volatile("s_waitcnt vmcnt(" #n ")" ::: "memory")
#define PG8_WAIT_L(n) asm volatile("s_waitcnt lgkmcnt(" #n ")" ::: "memory")
#define PG8_BAR __builtin_amdgcn_s_barrier()
#define PG8_SCHED __builtin_amdgcn_sched_barrier(0)
    Unit cur, nxt; int ui = 0;
    if (!S.next(0, cur)) return;
    f32x4 acc[2][2][4][2];
#pragma unroll
    for (int a = 0; a < 2; ++a)
#pragma unroll
        for (int b = 0; b < 2; ++b)
#pragma unroll
            for (int m = 0; m < 4; ++m)
#pragma unroll
                for (int n = 0; n < 2; ++n) acc[a][b][m][n] = (f32x4){0.f, 0.f, 0.f, 0.f};
    bf16x8 At[4][2], B0[2][2], B1[2][2];
    const char* cA = (const char*)g.A + (size_t)cur.pm * tstep; const char* cB = (const char*)g.Bt + (size_t)cur.pn * tstep;
    S.a_ready(cur);
    if constexpr (SP2) {
        PG8_STAGE(PG8_SB(0, 0), cB, voffB); PG8_STAGE(PG8_SB(0, 1), cB + hstep, voffB); PG8_STAGE(PG8_SA(0, 0), cA, voffA); PG8_STAGE(PG8_SA(0, 1), cA + hstep, voffA);
        if (wr == 1) PG8_BAR;
        PG8_WAIT_V(2); PG8_BAR;
        PG8_STAGE(PG8_SB(1, 0), cB + kstep, voffB); PG8_STAGE(PG8_SA(1, 0), cA + kstep, voffA); PG8_STAGE(PG8_SB(1, 1), cB + hstep + kstep, voffB);
        PG8_WAIT_V(6); PG8_BAR;
    } else {
        PG8_STAGE(PG8_SB(0, 0), cB, voffB); PG8_STAGE(PG8_SA(0, 0), cA, voffA); PG8_STAGE(PG8_SB(0, 1), cB + hstep, voffB); PG8_STAGE(PG8_SA(0, 1), cA + hstep, voffA);
        if (wr == 1) PG8_BAR;
        PG8_WAIT_V(4); PG8_BAR;
        PG8_STAGE(PG8_SB(1, 0), cB + kstep, voffB); PG8_STAGE(PG8_SA(1, 0), cA + kstep, voffA); PG8_STAGE(PG8_SB(1, 1), cB + hstep + kstep, voffB);
        PG8_WAIT_V(6); PG8_BAR;
    }
    for (;;) {
        const bool has_next = S.next(ui + 1, nxt);
        const char* nA = has_next ? (const char*)g.A + (size_t)nxt.pm * tstep : cA; const char* nB = has_next ? (const char*)g.Bt + (size_t)nxt.pn * tstep : cB;
        for (int t = 0; t < nt; t += 2) {
            const bool last = (t == nt - 2);
            const char* a1 = cA + (size_t)(t + 1) * kstep;
            const char* a2 = last ? nA : cA + (size_t)(t + 2) * kstep; const char* b2 = last ? nB : cB + (size_t)(t + 2) * kstep;
            const char* a3 = a2 + kstep; const char* b3 = b2 + kstep;
            if (last && has_next) S.a_ready(nxt);
            if constexpr (SP2) {
            PG8_LDB(B0, 0, 0); PG8_LDB(B1, 0, 1); PG8_SCHED; PG8_LDA(At, 0, 0); PG8_STAGE(PG8_SA(1, 1), a1 + hstep, voffA);
            PG8_WAIT_V(8); PG8_WAIT_L(0); PG8_BAR; PG8_MMA(0, 0, At, B0); PG8_MMA(0, 1, At, B1); PG8_BAR; PG8_SCHED;
            PG8_LDA(At, 0, 1); PG8_STAGE(PG8_SB(0, 0), b2, voffB); PG8_STAGE(PG8_SB(0, 1), b2 + hstep, voffB); PG8_STAGE(PG8_SA(0, 0), a2, voffA);
            PG8_WAIT_V(8); PG8_WAIT_L(0); PG8_BAR; PG8_MMA(1, 0, At, B0); PG8_MMA(1, 1, At, B1); PG8_BAR; PG8_SCHED;
            PG8_LDB(B0, 1, 0); PG8_LDB(B1, 1, 1); PG8_SCHED; PG8_LDA(At, 1, 0); PG8_STAGE(PG8_SA(0, 1), a2 + hstep, voffA);
            PG8_WAIT_V(8); PG8_WAIT_L(0); PG8_BAR; PG8_MMA(0, 0, At, B0); PG8_MMA(0, 1, At, B1); PG8_BAR; PG8_SCHED;
            PG8_LDA(At, 1, 1); PG8_STAGE(PG8_SB(1, 0), b3, voffB); PG8_STAGE(PG8_SB(1, 1), b3 + hstep, voffB); PG8_STAGE(PG8_SA(1, 0), a3, voffA);
            PG8_WAIT_V(8); PG8_WAIT_L(0); PG8_BAR; PG8_MMA(1, 0, At, B0); PG8_MMA(1, 1, At, B1); PG8_BAR; PG8_SCHED;
            } else {
            PG8_LDB(B0, 0, 0); PG8_SCHED; PG8_LDA(At, 0, 0); PG8_STAGE(PG8_SA(1, 1), a1 + hstep, voffA);
            PG8_WAIT_L(8); PG8_BAR; PG8_WAIT_L(0); PG8_MMA(0, 0, At, B0); PG8_BAR; PG8_SCHED;
            PG8_LDB(B1, 0, 1); PG8_STAGE(PG8_SB(0, 0), b2, voffB);
            PG8_BAR; PG8_WAIT_L(0); PG8_MMA(0, 1, At, B1); PG8_BAR;
            PG8_LDA(At, 0, 1); PG8_STAGE(PG8_SA(0, 0), a2, voffA);
            PG8_BAR; PG8_WAIT_L(0); PG8_MMA(1, 0, At, B0); PG8_BAR; PG8_SCHED;
            PG8_STAGE(PG8_SB(0, 1), b2 + hstep, voffB);
            PG8_WAIT_V(6); PG8_BAR; PG8_MMA(1, 1, At, B1); PG8_BAR;
            PG8_LDB(B0, 1, 0); PG8_SCHED; PG8_LDA(At, 1, 0); PG8_STAGE(PG8_SA(0, 1), a2 + hstep, voffA);
            PG8_WAIT_L(8); PG8_BAR; PG8_WAIT_L(0); PG8_MMA(0, 0, At, B0); PG8_BAR; PG8_SCHED;
            PG8_LDB(B1, 1, 1); PG8_STAGE(PG8_SB(1, 0), b3, voffB);
            PG8_BAR; PG8_WAIT_L(0); PG8_MMA(0, 1, At, B1); PG8_BAR;
            PG8_LDA(At, 1, 1); PG8_STAGE(PG8_SA(1, 0), a3, voffA);
            PG8_BAR; PG8_WAIT_L(0); PG8_MMA(1, 0, At, B0); PG8_BAR; PG8_SCHED;
            PG8_STAGE(PG8_SB(1, 1), b3 + hstep, voffB);
            PG8_WAIT_V(6); PG8_BAR; PG8_MMA(1, 1, At, B1); PG8_BAR;
            }
        }
        if constexpr (ALIGN_EPI) { if (wr == 0) PG8_BAR; }
        if constexpr (!Epi::AFTER_DRAIN) { E(acc, cur, wr, wc, fr, fq); S.done(cur); }
        if (!has_next) break;
#pragma unroll
        for (int a = 0; a < 2; ++a)
#pragma unroll
            for (int b = 0; b < 2; ++b)
#pragma unroll
                for (int m = 0; m < 4; ++m)
#pragma unroll
                    for (int n = 0; n < 2; ++n) acc[a][b][m][n] = (f32x4){0.f, 0.f, 0.f, 0.f};
        cur = nxt; cA = nA; cB = nB; ++ui;
        if constexpr (ALIGN_EPI) { if (wr == 1) PG8_BAR; }
    }
    PG8_WAIT_V(0);
    if constexpr (!ALIGN_EPI) { if (wr == 0) PG8_BAR; }
    PG8_BAR;
    if constexpr (Epi::AFTER_DRAIN) { E.fused(acc, cur, wr, wc, fr, fq, lds, wid, lane); S.done(cur); }
#undef PG8_SA
#undef PG8_SB
#undef PG8_STAGE
#undef PG8_LDA
#undef PG8_LDB
#undef PG8_MMA
#undef PG8_WAIT_V
#undef PG8_WAIT_L
#undef PG8_BAR
#undef PG8_SCHED
}
}
namespace att {
#define LAS __attribute__((address_space(3)))
typedef unsigned short bf16_t;
typedef short bf16x8 __attribute__((ext_vector_type(8)));
typedef float f32x4 __attribute__((ext_vector_type(4)));
typedef float f32x16 __attribute__((ext_vector_type(16)));
typedef unsigned u32x4 __attribute__((ext_vector_type(4)));
typedef unsigned u32x2 __attribute__((ext_vector_type(2)));
typedef float f32x2_t __attribute__((ext_vector_type(2))); typedef __bf16 bf16x2_t __attribute__((ext_vector_type(2)));
constexpr float LOG2E = 1.4426950408889634f;
constexpr int SEQ = 4096, MTOK = 65536;
__device__ __forceinline__ unsigned cvtpk(float lo, float hi) { f32x2_t v = {lo, hi}; bf16x2_t b = __builtin_convertvector(v, bf16x2_t); return __builtin_bit_cast(unsigned, b); }

#define GAS __attribute__((address_space(1)))
__device__ __forceinline__ void da_knorm(const bf16_t* QK_, float* kn_, int gw, int NGW, int lane) {
    const GAS bf16_t* QK = (const GAS bf16_t*)QK_; GAS float* kn = (GAS float*)kn_;
    for (int task = gw; task < 16 * 8 * 64; task += NGW) {
        const int b = task >> 9, h = (task >> 6) & 7, t = task & 63;
        const GAS u32x4* p = (const GAS u32x4*)(QK + ((size_t)b * SEQ + t * 64 + lane) * 2048 + 1024 + h * 128);
        float a[2] = {0.f, 0.f};
#pragma unroll
        for (int c = 0; c < 16; ++c) { const u32x4 w = p[c];
#pragma unroll
            for (int i = 0; i < 4; ++i) { const float lo = __uint_as_float(w[i] << 16), hi = __uint_as_float(w[i] & 0xffff0000u); a[c >> 3] += lo * lo + hi * hi; } }
        float m = __builtin_fmaxf(a[0], a[1]);
#pragma unroll
        for (int o = 1; o < 64; o <<= 1) m = __builtin_fmaxf(m, __shfl_xor(m, o));
        if (lane == 0) kn[task] = __builtin_sqrtf(m) * 1.002f;
    }
}
__device__ __forceinline__ void da_phase(LAS unsigned char* lds, const bf16_t* QK_, const bf16_t* VT_, bf16_t* AO_, const float* kn_,
                                         float lam, float outscale, const float* subln_, int G, int bx) {
    int tid_ = threadIdx.x; asm volatile("" : "+v"(tid_));
    const int tid = tid_, lane = tid & 63, wid = __builtin_amdgcn_readfirstlane(tid >> 6), q = lane & 31, hi = lane >> 5, mp = wid >> 2, wq = wid & 3;
    const GAS bf16_t* QK = (const GAS bf16_t*)QK_; const GAS bf16_t* VT = (const GAS bf16_t*)VT_; GAS bf16_t* AO = (GAS bf16_t*)AO_; const GAS float* kn = (const GAS float*)kn_; const GAS float* subln = (const GAS float*)subln_;
    const int pi = (q & ~12) | ((q & 8) >> 1) | ((q & 4) << 1);
    unsigned rk[4], rv[4];
#pragma unroll
    for (int s = 0; s < 4; ++s) { const int ck = 2 * s + hi; rk[s] = mp * 8192 + ck * 1024 + (pi ^ ck) * 16; }
#pragma unroll
    for (int jv = 0; jv < 4; ++jv) { const int cv = 2 * jv + hi; rv[jv] = 16384 + cv * 2048 + (q ^ cv) * 16; }
    const int kr = tid >> 4, kch = tid & 15, vd = tid >> 3, vc = tid & 7;
    const unsigned kdst = (kch >> 3) * 8192 + (kch & 7) * 1024 + (kr ^ (kch & 7)) * 16, vdst = 16384 + vc * 2048 + (vd ^ vc) * 16;
    LAS float* xch = (LAS float*)(lds + 65536) + wq * 4096 + lane;
    LAS float* red = (LAS float*)(lds + 131072);
    for (int un = bx; un < 4096; un += G) {
        int b, h, qb; if (G == 256) { const int k = un >> 8; b = k; h = (bx + k) & 7; qb = ((bx >> 3) + 16 * (k & 1)) & 31; } else { b = un >> 8; h = (un >> 5) & 7; qb = un & 31; }
        const float nslope2 = -__builtin_amdgcn_exp2f(-(float)(h + 1)) * LOG2E;
        const size_t tokb = (size_t)b * SEQ;
        const int qpos = qb * 128 + wq * 32 + q;
        const GAS bf16_t* ksrc = QK + (tokb + kr) * 2048 + 1024 + h * 128 + kch * 8;
        const GAS bf16_t* vsrc = VT + (size_t)(h * 128 + vd) * MTOK + tokb + vc * 8;
        u32x4 sa0, sa1, sa2, sa3, sb0, sb1, sb2, sb3;
#define DA_LOADT(S, t) do { S##0 = *(const GAS u32x4*)(ksrc + (size_t)(t) * 64 * 2048); S##1 = *(const GAS u32x4*)(ksrc + (size_t)(t) * 64 * 2048 + 32 * 2048); \
                         S##2 = *(const GAS u32x4*)(vsrc + (t) * 64); S##3 = *(const GAS u32x4*)(vsrc + (size_t)64 * MTOK + (t) * 64); } while (0)
#define DA_STORET(S, bo) do { *(LAS u32x4*)(lds + (bo) + kdst) = S##0; *(LAS u32x4*)(lds + (bo) + kdst + 512) = S##1; *(LAS u32x4*)(lds + (bo) + vdst) = S##2; *(LAS u32x4*)(lds + (bo) + vdst + 1024) = S##3; } while (0)
        const int d0 = 2 * qb, d1 = 2 * qb + 1;
        DA_LOADT(sa, d0); DA_LOADT(sb, d1);
        bf16x8 qf[4]; float qn2 = 0.f;
        { const GAS bf16_t* qp = QK + (tokb + qpos) * 2048 + h * 128 + mp * 64 + 8 * hi;
#pragma unroll
          for (int s = 0; s < 4; ++s) { qf[s] = *(const GAS bf16x8*)(qp + 16 * s);
#pragma unroll
              for (int i = 0; i < 8; ++i) { const float v = __uint_as_float(((unsigned)(unsigned short)qf[s][i]) << 16); qn2 += v * v; } } }
        qn2 += __shfl_xor(qn2, 32);
        const float knl = kn[(b * 8 + h) * 64 + lane];
        f32x16 o[4];
#pragma unroll
        for (int d = 0; d < 4; ++d) o[d] = f32x16{};
        float mref = 0.f, l = 0.f;
#define DA_COMPUTE(t, bo, FIRST, LIN) do { \
            f32x16 p[2]; \
            const float dbase = (float)((t) * 64 + 8 * hi - qpos); \
            const float sg_ = ((t) < d0) ? -nslope2 : nslope2, A_ = dbase * sg_ - mref;     \
            _Pragma("unroll") for (int hf = 0; hf < 2; ++hf) { \
                if (LIN) { _Pragma("unroll") for (int r = 0; r < 16; ++r) p[hf][r] = __builtin_fmaf((float)(32 * hf + 16 * (r >> 3) + (r & 7)), sg_, A_); } \
                else { _Pragma("unroll") for (int r = 0; r < 16; ++r) p[hf][r] = __builtin_fmaf(__builtin_fabsf(dbase + (float)(32 * hf + 16 * (r >> 3) + (r & 7))), nslope2, -mref); } } \
              \
            _Pragma("unroll") for (int s = 0; s < 4; ++s) _Pragma("unroll") for (int hf = 0; hf < 2; ++hf) { \
                const bf16x8 kf = *(const LAS bf16x8*)(lds + (bo) + rk[s] + hf * 512); p[hf] = __builtin_amdgcn_mfma_f32_32x32x16_bf16(kf, qf[s], p[hf], 0, 0, 0); } \
            float mx = p[0][0]; \
            _Pragma("unroll") for (int r = 1; r < 16; ++r) mx = __builtin_fmaxf(mx, p[0][r]); \
            _Pragma("unroll") for (int r = 0; r < 16; ++r) mx = __builtin_fmaxf(mx, p[1][r]); \
            mx = __builtin_fmaxf(mx, __shfl_xor(mx, 32)); \
              \
            if (!(FIRST) && !__any(mx > -36.0f)) break; \
            if (FIRST) { mref = mx; \
                _Pragma("unroll") for (int r = 0; r < 16; ++r) { p[0][r] -= mx; p[1][r] -= mx; } } \
            else if (__any(mx > 8.0f)) { const float dl = __builtin_fmaxf(mx, 0.f); mref += dl; const float f = __builtin_amdgcn_exp2f(-dl); l *= f; \
                _Pragma("unroll") for (int r = 0; r < 16; ++r) { p[0][r] -= dl; p[1][r] -= dl; } \
                _Pragma("unroll") for (int d = 0; d < 4; ++d) _Pragma("unroll") for (int r = 0; r < 16; ++r) o[d][r] *= f; } \
              \
            float sacc = 0.f; bf16x8 pf[2][2]; \
            _Pragma("unroll") for (int r = 0; r < 16; ++r) { p[0][r] = __builtin_amdgcn_exp2f(p[0][r]); sacc += p[0][r]; } \
            _Pragma("unroll") for (int u = 0; u < 2; ++u) { u32x4 w; w.x = cvtpk(p[0][8 * u], p[0][8 * u + 1]); w.y = cvtpk(p[0][8 * u + 2], p[0][8 * u + 3]); \
                    w.z = cvtpk(p[0][8 * u + 4], p[0][8 * u + 5]); w.w = cvtpk(p[0][8 * u + 6], p[0][8 * u + 7]); pf[0][u] = __builtin_bit_cast(bf16x8, w); } \
            _Pragma("unroll") for (int u = 0; u < 2; ++u) _Pragma("unroll") for (int d = 0; d < 4; ++d) { \
                    const bf16x8 vf = *(const LAS bf16x8*)(lds + (bo) + rv[u] + d * 512); o[d] = __builtin_amdgcn_mfma_f32_32x32x16_bf16(vf, pf[0][u], o[d], 0, 0, 0); } \
            _Pragma("unroll") for (int r = 0; r < 16; ++r) { p[1][r] = __builtin_amdgcn_exp2f(p[1][r]); sacc += p[1][r]; } \
            _Pragma("unroll") for (int u = 0; u < 2; ++u) { u32x4 w; w.x = cvtpk(p[1][8 * u], p[1][8 * u + 1]); w.y = cvtpk(p[1][8 * u + 2], p[1][8 * u + 3]); \
                    w.z = cvtpk(p[1][8 * u + 4], p[1][8 * u + 5]); w.w = cvtpk(p[1][8 * u + 6], p[1][8 * u + 7]); pf[1][u] = __builtin_bit_cast(bf16x8, w); } \
            _Pragma("unroll") for (int i_ = 0; i_ < 8; ++i_) { __builtin_amdgcn_sched_group_barrier(0x100, 1, 0); __builtin_amdgcn_sched_group_barrier(0x008, 1, 0); __builtin_amdgcn_sched_group_barrier(0x002, 5, 0); } \
            l += sacc; \
            _Pragma("unroll") for (int u = 0; u < 2; ++u) _Pragma("unroll") for (int d = 0; d < 4; ++d) { \
                    const bf16x8 vf = *(const LAS bf16x8*)(lds + (bo) + rv[2 + u] + d * 512); o[d] = __builtin_amdgcn_mfma_f32_32x32x16_bf16(vf, pf[1][u], o[d], 0, 0, 0); } \
        } while (0)
        DA_STORET(sa, 0);
        __syncthreads();
        DA_COMPUTE(d0, 0, true, false);
        DA_STORET(sb, 32768);
        __syncthreads();
        DA_COMPUTE(d1, 32768, false, false);
        { float lmin = mref, qmx = qn2;
#pragma unroll
          for (int o_ = 1; o_ < 64; o_ <<= 1) { lmin = __builtin_fminf(lmin, __shfl_xor(lmin, o_)); qmx = __builtin_fmaxf(qmx, __shfl_xor(qmx, o_)); }
          if (lane == 0) { red[2 * wid] = lmin; red[2 * wid + 1] = qmx; } }
        __syncthreads();
        unsigned long long mask;
        { float Lmin = red[0], Q2 = red[1];
#pragma unroll
          for (int w = 1; w < 8; ++w) { Lmin = __builtin_fminf(Lmin, red[2 * w]); Q2 = __builtin_fmaxf(Q2, red[2 * w + 1]); }
          const float Qmax = __builtin_sqrtf(Q2) * 1.002f;
          const int t = lane, mind = (t < d0) ? (qb * 128 - (t * 64 + 63)) : (t * 64 - (qb * 128 + 127));
          const float bound = Qmax * knl + nslope2 * (float)mind;
          const bool need = (t != d0) && (t != d1) && (bound >= Lmin - 36.0f);
          mask = __ballot(need); }
        if (mask) {
#define DA_POP(v) do { v = -1; if (mask) { v = (int)__builtin_ctzll(mask); mask &= mask - 1; } } while (0)
            int cur, n1, n2; DA_POP(cur); DA_POP(n1);
            unsigned bo = 0;
            DA_LOADT(sa, cur); DA_LOADT(sb, (n1 >= 0 ? n1 : cur));
            DA_STORET(sa, 0);
            __syncthreads();
#define DA_STEP(X, Y) { DA_POP(n2); DA_LOADT(Y, (n2 >= 0 ? n2 : cur)); DA_COMPUTE(cur, bo, false, true); if (n1 < 0) break; DA_STORET(X, bo ^ 32768); __syncthreads(); bo ^= 32768; cur = n1; n1 = n2; }
            for (;;) { DA_STEP(sb, sa) DA_STEP(sa, sb) }
#undef DA_STEP
#undef DA_POP
        }
        __syncthreads();
#undef DA_LOADT
#undef DA_STORET
#undef DA_COMPUTE
        l += __shfl_xor(l, 32);
        const float inv = 1.0f / l;
        if (mp == 1) {
#pragma unroll
            for (int d = 0; d < 4; ++d)
#pragma unroll
                for (int r = 0; r < 16; ++r) xch[(d * 16 + r) * 64] = o[d][r] * inv;
        }
        __syncthreads();
        if (mp == 0) {
            float ss = 0.f;
#pragma unroll
            for (int d = 0; d < 4; ++d)
#pragma unroll
                for (int r = 0; r < 16; ++r) { const float v = o[d][r] * inv - lam * xch[(d * 16 + r) * 64]; o[d][r] = v; ss += v * v; }
            ss += __shfl_xor(ss, 32);
            const float rs = rsqrtf(ss * (1.0f / 128.0f) + 1e-5f) * outscale;
            GAS bf16_t* op = AO + (tokb + qpos) * 1024 + h * 128 + 4 * hi;
#pragma unroll
            for (int d = 0; d < 4; ++d)
#pragma unroll
                for (int r4 = 0; r4 < 4; ++r4) { const f32x4 g = *(const GAS f32x4*)(subln + 32 * d + 8 * r4 + 4 * hi);
                    u32x2 w; w.x = cvtpk(o[d][4 * r4] * rs * g[0], o[d][4 * r4 + 1] * rs * g[1]); w.y = cvtpk(o[d][4 * r4 + 2] * rs * g[2], o[d][4 * r4 + 3] * rs * g[3]);
                    *(GAS u32x2*)(op + 32 * d + 8 * r4) = w; }
        }
    }
}
#undef GAS

#define GAS __attribute__((address_space(1)))
constexpr int NA_RING = 147456, NA_TB = NA_RING;
__device__ __forceinline__ void na_phase(LAS unsigned char* lds, const bf16_t* QK_, const bf16_t* VT_, bf16_t* AO_, const float* rpb_, int G, int bx) {
    int tid_ = threadIdx.x; asm volatile("" : "+v"(tid_));
    const int tid = tid_, lane = tid & 63, wid = __builtin_amdgcn_readfirstlane(tid >> 6), n = lane & 15, g = lane >> 4;
    const GAS bf16_t* QK = (const GAS bf16_t*)QK_; const GAS bf16_t* VT = (const GAS bf16_t*)VT_; GAS bf16_t* AO = (GAS bf16_t*)AO_; const GAS float* rpb = (const GAS float*)rpb_;
    LAS float* tb = (LAS float*)(lds + NA_TB);
    const int rq = wid >> 2, qg = wid & 3, c0 = 16 * qg, cw0 = (qg == 0) ? 0 : (qg == 1) ? 8 : (qg == 2) ? 24 : 32;
    const int c = c0 + n, cs = min(max(c - 8, 0), 48);
    unsigned ka[2], va[2];
#pragma unroll
    for (int ks = 0; ks < 2; ++ks) ka[ks] = (cw0 + n) * 128 + (((4 * ks + g) ^ (n & 7)) * 16);
    { const int c8 = (cw0 >> 2) + g; va[0] = 8192 + n * 128 + (((c8 >> 1) ^ (n & 7)) * 16) + (c8 & 1) * 8; va[1] = 8192 + n * 128 + ((((c8 >> 1) + 2) ^ (n & 7)) * 16) + (c8 & 1) * 8; }
    const int tr = tid >> 3, tc = tid & 7;
    const unsigned sdst = tr * 128 + ((tc ^ (tr & 7)) * 16);
    int bidx[8]; unsigned vmask = 0;
#pragma unroll
    for (int j8 = 0; j8 < 8; ++j8) { const int kc = cw0 + 16 * (j8 >> 2) + 4 * g + (j8 & 3); bidx[j8] = min(max(kc - c + 15, 0), 30); vmask |= ((unsigned)(kc - cs) < 16u) ? (1u << j8) : 0u; }
    for (int un = bx; un < 256; un += G) {
        const int b = un >> 4, h = un & 15;
        __syncthreads();
        for (int i = tid; i < 15 * 31; i += 512) tb[i] = rpb[h * 465 + i] * LOG2E;
        const GAS bf16_t* ksrc = QK + ((size_t)b * SEQ + tr) * 2048 + 1024 + h * 64 + tc * 8;
        const GAS bf16_t* vsrc = VT + (size_t)(h * 64 + tr) * MTOK + (size_t)b * SEQ + tc * 8;
#define NA_LDK(row) (*(const GAS u32x4*)(ksrc + (size_t)(row) * 64 * 2048))
#define NA_LDV(row) (*(const GAS u32x4*)(vsrc + (row) * 64))
#define NA_ST(row, kv, vv_) do { const unsigned so_ = (unsigned)((row) % 9) * 16384u + sdst; *(LAS u32x4*)(lds + so_) = (kv); *(LAS u32x4*)(lds + so_ + 8192) = (vv_); } while (0)
#pragma unroll
        for (int row = 0; row < 8; row += 4) { const u32x4 a0 = NA_LDK(row), b0 = NA_LDV(row), a1 = NA_LDK(row + 1), b1 = NA_LDV(row + 1), a2 = NA_LDK(row + 2), b2 = NA_LDV(row + 2), a3 = NA_LDK(row + 3), b3 = NA_LDV(row + 3);
            NA_ST(row, a0, b0); NA_ST(row + 1, a1, b1); NA_ST(row + 2, a2, b2); NA_ST(row + 3, a3, b3); }
        int loaded_hi = 7;
        const GAS bf16_t* qbase = QK + ((size_t)b * SEQ + rq * 64 + c0 + n) * 2048 + h * 64 + 8 * g;
        bf16x8 q0 = *(const GAS bf16x8*)qbase, q1 = *(const GAS bf16x8*)(qbase + 32);
        __syncthreads();
        for (int s = 0; s < 32; ++s) {
            const int tgt = (s < 31) ? (min(max(2 * s - 1, 0), 56) + 7) : loaded_hi;
            const int nnew = tgt - loaded_hi;
            const int ra_ = min(loaded_hi + 1, 63), rb_ = min(loaded_hi + 2, 63);
            const u32x4 p0 = NA_LDK(ra_), p1 = NA_LDV(ra_), p2 = NA_LDK(rb_), p3 = NA_LDV(rb_);
            const int sn = (s < 31) ? s + 1 : s;
            const bf16x8 q0n = *(const GAS bf16x8*)(qbase + (size_t)sn * 128 * 2048), q1n = *(const GAS bf16x8*)(qbase + (size_t)sn * 128 * 2048 + 32);
            const int r = 2 * s + rq, rs = min(max(r - 4, 0), 56);
            const int slot0 = rs % 9;
            float bvl[8][8];
#pragma unroll
            for (int kr = 0; kr < 8; ++kr) { const LAS float* rowp = tb + (rs + kr - r + 7) * 31;
#pragma unroll
                for (int j8 = 0; j8 < 8; ++j8) bvl[kr][j8] = rowp[bidx[j8]]; }
            __builtin_amdgcn_sched_group_barrier(0x100, 64, 0);
            f32x4 st[16];
#pragma unroll
            for (int kp = 0; kp < 4; ++kp) {
                bf16x8 kf[2][2][2];
#pragma unroll
                for (int k2 = 0; k2 < 2; ++k2) { int sl = slot0 + 2 * kp + k2; sl = (sl >= 9) ? sl - 9 : sl; const unsigned base = (unsigned)sl * 16384u;
#pragma unroll
                    for (int hf = 0; hf < 2; ++hf) { kf[k2][hf][0] = *(const LAS bf16x8*)(lds + base + hf * 2048 + ka[0]); kf[k2][hf][1] = *(const LAS bf16x8*)(lds + base + hf * 2048 + ka[1]); } }
#pragma unroll
                for (int k2 = 0; k2 < 2; ++k2)
#pragma unroll
                    for (int hf = 0; hf < 2; ++hf) { f32x4 a = __builtin_amdgcn_mfma_f32_16x16x32_bf16(kf[k2][hf][0], q0, (f32x4){0.f, 0.f, 0.f, 0.f}, 0, 0, 0);
                        st[(2 * kp + k2) * 2 + hf] = __builtin_amdgcn_mfma_f32_16x16x32_bf16(kf[k2][hf][1], q1, a, 0, 0, 0); }
                __builtin_amdgcn_sched_group_barrier(0x100, 8, 0); __builtin_amdgcn_sched_group_barrier(0x008, 8, 0);
            }
            float mx = -INFINITY;
#pragma unroll
            for (int kr = 0; kr < 8; ++kr)
#pragma unroll
                for (int j8 = 0; j8 < 8; ++j8) { const float v = ((vmask >> j8) & 1u) ? st[kr * 2 + (j8 >> 2)][j8 & 3] + bvl[kr][j8] : -INFINITY; st[kr * 2 + (j8 >> 2)][j8 & 3] = v; mx = __builtin_fmaxf(mx, v); }
            mx = __builtin_fmaxf(mx, __shfl_xor(mx, 16)); mx = __builtin_fmaxf(mx, __shfl_xor(mx, 32));
            float l = 0.f;
#pragma unroll
            for (int ti = 0; ti < 16; ++ti)
#pragma unroll
                for (int i = 0; i < 4; ++i) { const float e = __builtin_amdgcn_exp2f(st[ti][i] - mx); st[ti][i] = e; l += e; }
            l += __shfl_xor(l, 16); l += __shfl_xor(l, 32);
            const float inv = 1.0f / l;
            f32x4 o[4];
#pragma unroll
            for (int dt = 0; dt < 4; ++dt) o[dt] = (f32x4){0.f, 0.f, 0.f, 0.f};
#pragma unroll
            for (int kp = 0; kp < 4; ++kp) {
                u32x2 vv[2][4][2];
#pragma unroll
                for (int k2 = 0; k2 < 2; ++k2) { int sl = slot0 + 2 * kp + k2; sl = (sl >= 9) ? sl - 9 : sl; const unsigned base = (unsigned)sl * 16384u;
#pragma unroll
                    for (int dt = 0; dt < 4; ++dt) { vv[k2][dt][0] = *(const LAS u32x2*)(lds + base + dt * 2048 + va[0]); vv[k2][dt][1] = *(const LAS u32x2*)(lds + base + dt * 2048 + va[1]); } }
#pragma unroll
                for (int k2 = 0; k2 < 2; ++k2) { const int kr = 2 * kp + k2;
                    u32x4 w; w.x = cvtpk(st[2 * kr][0], st[2 * kr][1]); w.y = cvtpk(st[2 * kr][2], st[2 * kr][3]); w.z = cvtpk(st[2 * kr + 1][0], st[2 * kr + 1][1]); w.w = cvtpk(st[2 * kr + 1][2], st[2 * kr + 1][3]);
                    const bf16x8 pf = __builtin_bit_cast(bf16x8, w);
#pragma unroll
                    for (int dt = 0; dt < 4; ++dt) { const u32x4 v4 = {vv[k2][dt][0].x, vv[k2][dt][0].y, vv[k2][dt][1].x, vv[k2][dt][1].y};
                        o[dt] = __builtin_amdgcn_mfma_f32_16x16x32_bf16(__builtin_bit_cast(bf16x8, v4), pf, o[dt], 0, 0, 0); } }
                __builtin_amdgcn_sched_group_barrier(0x100, 16, 0); __builtin_amdgcn_sched_group_barrier(0x008, 8, 0);
            }
            GAS bf16_t* op = AO + ((size_t)b * SEQ + r * 64 + c0 + n) * 1024 + h * 64 + 4 * g;
#pragma unroll
            for (int dt = 0; dt < 4; ++dt) { u32x2 w; w.x = cvtpk(o[dt][0] * inv, o[dt][1] * inv); w.y = cvtpk(o[dt][2] * inv, o[dt][3] * inv); *(GAS u32x2*)(op + 16 * dt) = w; }
            __syncthreads();
            if (nnew >= 1) NA_ST(loaded_hi + 1, p0, p1);
            if (nnew >= 2) NA_ST(loaded_hi + 2, p2, p3);
            loaded_hi = tgt; q0 = q0n; q1 = q1n;
            __syncthreads();
        }
#undef NA_LDK
#undef NA_LDV
#undef NA_ST
    }
}
#undef GAS
#undef LAS
}
#define LAS __attribute__((address_space(3)))
typedef unsigned short bf16;
typedef unsigned v4u __attribute__((ext_vector_type(4)));
typedef unsigned v2u __attribute__((ext_vector_type(2)));
typedef float f32x4 __attribute__((ext_vector_type(4)));
constexpr int NWAVES = 8, NTHR = 512;
constexpr int M = 65536, D = 1024, FF = 2816, PLE = 256, DEPTH = 4, SEQ = 4096;
constexpr size_t MiB = 1u << 20;
constexpr size_t WS_SSQ = 913 * MiB;
constexpr size_t WS_W = 4 * MiB, W_LAYER = 27 * MiB;
constexpr size_t WO_QKV = 0, WO_O = 6 * MiB, WO_GU = 8 * MiB, WO_DN = 19 * MiB, WO_PG = 19 * MiB + 5632 * 1024, WO_PP = WO_PG + 2 * MiB;
constexpr size_t WS_PB = 112 * MiB;
constexpr size_t WS_HB0 = 144 * MiB, WS_HB1 = 272 * MiB;
constexpr size_t WS_QK = 400 * MiB, WS_VT = 656 * MiB;
constexpr size_t WS_HID = 400 * MiB;
constexpr size_t WS_AO = 784 * MiB;
constexpr size_t WS_BAR = 912 * MiB;
constexpr size_t WS_KN = 920 * MiB;
constexpr size_t WS_END = 921 * MiB;
static_assert(WO_PP + (size_t)1024 * 256 * 2 <= W_LAYER && WS_W + 4 * W_LAYER <= WS_PB && WS_HID + (size_t)M * FF * 2 <= WS_AO, "ws map");
constexpr int LDS_BYTES = 155648;

struct Params {
    const float* in[22];
    float* out; unsigned char* ws;
};

__device__ __forceinline__ unsigned f2bf(float f) { unsigned u = __builtin_bit_cast(unsigned, f); return (u + 0x7fffu + ((u >> 16) & 1u)) >> 16; }
__device__ __forceinline__ unsigned pk2(float lo, float hi) { return f2bf(lo) | (f2bf(hi) << 16); }
__device__ __forceinline__ float wave_sum(float v) {
#pragma unroll
    for (int o = 1; o < 64; o <<= 1) v += __shfl_xor(v, o);
    return v;
}
__device__ __forceinline__ void transpose_item(const float* __restrict__ W, int K, int N, const float* __restrict__ gk, bf16* __restrict__ WT, int grp, int gstride, int goff, LAS float* scr, int item, int lane) {
    const int nblk = N / 32, kb = item / nblk, nb = item % nblk, k0 = 64 * kb, n0 = 32 * nb;
    float wv_[32], gs_[32];
#pragma unroll
    for (int i = 0; i < 32; ++i) { const int kk = 2 * i + (lane >> 5); gs_[i] = gk ? ((const __attribute__((address_space(1))) float*)gk)[k0 + kk] : 1.f; wv_[i] = ((const __attribute__((address_space(1))) float*)W)[(size_t)(k0 + kk) * N + n0 + (lane & 31)]; }
#pragma unroll
    for (int i = 0; i < 32; ++i) { const int kk = 2 * i + (lane >> 5); scr[kk * 33 + (lane & 31)] = wv_[i] * gs_[i]; }
    asm volatile("s_waitcnt lgkmcnt(0)" ::: "memory");
    const int c = lane & 7;
#pragma unroll
    for (int j = 0; j < 4; ++j) { const int n = (lane >> 3) + 8 * j; const LAS float* s = scr + (8 * c) * 33 + n;
        v4u o; o.x = pk2(s[0 * 33], s[1 * 33]); o.y = pk2(s[2 * 33], s[3 * 33]); o.z = pk2(s[4 * 33], s[5 * 33]); o.w = pk2(s[6 * 33], s[7 * 33]);
        const int nn = n0 + n, orow = (nn / grp) * gstride + goff + (nn % grp);
        *(__attribute__((address_space(1))) v4u*)(WT + (size_t)orow * K + k0 + 8 * c) = o; }
    asm volatile("s_waitcnt lgkmcnt(0)" ::: "memory");
}

__global__ void __launch_bounds__(NTHR) fwd_megakernel(Params P) {
    extern __shared__ __attribute__((aligned(16))) unsigned char lds_raw[];
    cg::grid_group grid = cg::this_grid();
    unsigned bar_gen = 0;
#define GRID_SYNC() do { asm volatile("s_waitcnt vmcnt(0) lgkmcnt(0)" ::: "memory"); __syncthreads(); \
        if (threadIdx.x == 0) { __builtin_amdgcn_fence(__ATOMIC_RELEASE, "agent"); asm volatile("s_waitcnt vmcnt(0)" ::: "memory"); bar_gen += 1u; \
              \
            const unsigned ngrp_ = (gridDim.x & 7u) ? 1u : 8u, gsz_ = gridDim.x / ngrp_; \
            unsigned* top_ = (unsigned*)(P.ws + WS_BAR); unsigned* grp_ = top_ + 64u * (1u + (ngrp_ == 8u ? (blockIdx.x & 7u) : 0u)); \
            const unsigned old_ = __hip_atomic_fetch_add(grp_, 1u, __ATOMIC_RELAXED, __HIP_MEMORY_SCOPE_AGENT); \
            if (old_ + 1u == gsz_ * bar_gen) __hip_atomic_fetch_add(top_, 1u, __ATOMIC_RELAXED, __HIP_MEMORY_SCOPE_AGENT); \
            while (__hip_atomic_load(top_, __ATOMIC_RELAXED, __HIP_MEMORY_SCOPE_AGENT) < ngrp_ * bar_gen) __builtin_amdgcn_s_sleep(1); \
            __builtin_amdgcn_fence(__ATOMIC_ACQUIRE, "agent"); asm volatile("s_waitcnt vmcnt(0)" ::: "memory"); } \
        __syncthreads(); } while (0)
    LAS unsigned char* lds = (LAS unsigned char*)lds_raw;
#define OPQ_TID() int tid = threadIdx.x; asm volatile("" : "+v"(tid)); const int lane = tid & 63, wave = __builtin_amdgcn_readfirstlane(tid >> 6); \
        const int G = gridDim.x, bx = blockIdx.x, gw = bx * NWAVES + wave, NGW = G * NWAVES; (void)lane; (void)gw; (void)NGW; (void)G; (void)bx
#define OPQ_WS() unsigned char* ws = P.ws; asm volatile("" : "+s"(ws)); pg8::u64* ssq = (pg8::u64*)(ws + WS_SSQ); float* out = P.out; asm volatile("" : "+s"(out))
#define OPQ_LAYER() OPQ_WS(); int lo = li; asm volatile("" : "+s"(lo)); const int j = lo >> 1; unsigned char* wl = ws + WS_W + (size_t)lo * W_LAYER; \
        bf16* HBc = (bf16*)(ws + ((lo & 1) ? WS_HB1 : WS_HB0)); bf16* HBn = (bf16*)(ws + ((lo & 1) ? WS_HB0 : WS_HB1)); \
        pg8::u64* ssq_mix = ssq + (size_t)(3 * lo) * M; pg8::u64* ssq_ffn = ssq_mix + M; pg8::u64* ssq_ple = ssq_ffn + M; pg8::u64* ssq_nxt = ssq_ple + M; \
        bf16* QK = (bf16*)(ws + WS_QK); bf16* VT = (bf16*)(ws + WS_VT); bf16* HID = (bf16*)(ws + WS_HID); bf16* AO = (bf16*)(ws + WS_AO); bf16* PB = (bf16*)(ws + WS_PB); \
        (void)j; (void)wl; (void)HBc; (void)HBn; (void)ssq_mix; (void)ssq_ffn; (void)ssq_ple; (void)ssq_nxt; (void)QK; (void)VT; (void)HID; (void)AO; (void)PB
    {
        OPQ_TID(); OPQ_WS(); (void)out; bf16* HB0 = (bf16*)(ws + WS_HB0);
        const float* x = P.in[0]; const float* norm_mix = P.in[2]; const float* norm_ffn = P.in[3]; const float* norm_ple = P.in[4];
        LAS float* scr = (LAS float*)(lds + wave * 16384);
        constexpr int I_QKV = 16 * 96, I_O = 16 * 32, I_G = 16 * 88, I_DN = 44 * 32, I_PG = 16 * 32, I_PP = 4 * 32, I_LAYER = I_QKV + I_O + 2 * I_G + I_DN + I_PG + I_PP;
        for (int it = gw; it < DEPTH * I_LAYER; it += NGW) {
            const int li = it / I_LAYER, j = li >> 1; int r = it % I_LAYER;
            unsigned char* wl = ws + WS_W + (size_t)li * W_LAYER;
            if (r < I_QKV) { const float* W = (li & 1) ? P.in[13] + (size_t)j * D * 3 * D : P.in[6] + (size_t)j * D * 3 * D;
                transpose_item(W, D, 3 * D, norm_mix + li * D, (bf16*)(wl + WO_QKV), 3 * D, 0, 0, scr, r, lane); continue; } r -= I_QKV;
            if (r < I_O) { const float* W = (li & 1) ? P.in[16] + (size_t)j * D * D : P.in[7] + (size_t)j * D * D;
                transpose_item(W, D, D, nullptr, (bf16*)(wl + WO_O), D, 0, 0, scr, r, lane); continue; } r -= I_O;
            if (r < I_G) { transpose_item(P.in[17] + (size_t)li * D * FF, D, FF, norm_ffn + li * D, (bf16*)(wl + WO_GU), 128, 256, 0, scr, r, lane); continue; } r -= I_G;
            if (r < I_G) { transpose_item(P.in[18] + (size_t)li * D * FF, D, FF, norm_ffn + li * D, (bf16*)(wl + WO_GU), 128, 256, 128, scr, r, lane); continue; } r -= I_G;
            if (r < I_DN) { transpose_item(P.in[19] + (size_t)li * FF * D, FF, D, nullptr, (bf16*)(wl + WO_DN), D, 0, 0, scr, r, lane); continue; } r -= I_DN;
            if (r < I_PG) { transpose_item(P.in[21] + (size_t)li * D * D, D, D, norm_ple + li * D, (bf16*)(wl + WO_PG), D, 0, 0, scr, r, lane); continue; } r -= I_PG;
            transpose_item(P.in[20] + (size_t)li * PLE * D, PLE, D, nullptr, (bf16*)(wl + WO_PP), D, 0, 0, scr, r, lane);
        }
        for (int g32 = gw; g32 < M / 32; g32 += NGW) {
            float keep = 0.f;
#pragma unroll 4
            for (int rr = 0; rr < 32; ++rr) {
                const int m = g32 * 32 + rr;
                const f32x4* xr = (const f32x4*)(x + (size_t)m * D) + lane; f32x4 v[4]; float sq = 0.f;
#pragma unroll
                for (int jj = 0; jj < 4; ++jj) { v[jj] = xr[64 * jj]; sq += (v[jj].x * v[jj].x + v[jj].y * v[jj].y) + (v[jj].z * v[jj].z + v[jj].w * v[jj].w); }
                sq = wave_sum(sq); if (lane == rr) keep = sq;
                v2u* o8 = (v2u*)(HB0 + (size_t)m * D) + lane;
#pragma unroll
                for (int jj = 0; jj < 4; ++jj) { v2u w; w.x = pk2(v[jj].x, v[jj].y); w.y = pk2(v[jj].z, v[jj].w); o8[64 * jj] = w; }
            }
            if (lane < 32) ssq[g32 * 32 + lane] = (pg8::u64)(keep * pg8::SSQ_FIX + 0.5f);
        }
        for (int i = bx * NTHR + tid; i < 12 * M / 2; i += G * NTHR) ((v4u*)(ssq + M))[i] = (v4u){0u, 0u, 0u, 0u};
    }
    GRID_SYNC();
    grid.sync();

#pragma unroll 1
    for (int li = 0; li < DEPTH; ++li) {
        const bool is_da = (li & 1) == 0;
        {
            OPQ_TID(); OPQ_LAYER();
            const float* bqkv = is_da ? nullptr : P.in[14] + (size_t)j * 3 * D;
            { pg8::Gemm g{HBc, (const bf16*)(wl + WO_QKV), M, 2 * D, D}; pg8::StaticOrder S; S.init(M, 2 * D, G, bx);
              pg8::EpiQK E{QK, 2 * D, ssq_mix, bqkv, D, 0.125f * 1.4426950408889634f};
              GEMM_CALL_EpiQK(pg8::gemm_phase<pg8::EpiQK, pg8::StaticOrder, true, true>(lds, g, S, E)); }
            { pg8::Gemm g{(const bf16*)(wl + WO_QKV) + (size_t)2 * D * D, HBc, D, M, D}; pg8::StaticOrder S; S.init(D, M, G, bx);
              pg8::EpiVT E{VT, M, ssq_mix, bqkv ? bqkv + 2 * D : nullptr};
              GEMM_CALL_EpiVT(pg8::gemm_phase<pg8::EpiVT, pg8::StaticOrder, true, true>(lds, g, S, E)); }
        }
        GRID_SYNC();
        { OPQ_TID(); OPQ_LAYER(); const float* pin = P.in[1];
        if (is_da) {
            float d1 = 0.f, d2 = 0.f;
            { const float* q1 = P.in[8] + j * 64; const float* k1 = P.in[9] + j * 64; const float* q2 = P.in[10] + j * 64; const float* k2 = P.in[11] + j * 64;
              d1 = wave_sum(q1[lane] * k1[lane]); d2 = wave_sum(q2[lane] * k2[lane]); }
            const float lam_init = 0.8f - 0.6f * __expf(-0.3f * (float)li);
            const float lam = __expf(d1) - __expf(d2) + lam_init;
#ifndef NO_DA
            float* KN = (float*)(ws + WS_KN);
            att::da_knorm(QK, KN, gw, NGW, lane);
            GRID_SYNC();
            att::da_phase(lds, QK, VT, AO, KN, lam, 1.0f - lam_init, P.in[12] + j * 128, G, bx);
#else
            for (int i = bx * NTHR + tid; i < M * D / 8; i += G * NTHR) ((v4u*)AO)[i] = (v4u){0u, 0u, 0u, 0u};
#endif
        } else {
#ifndef NO_NA
            att::na_phase(lds, QK, VT, AO, P.in[15] + (size_t)j * 16 * 15 * 31, G, bx);
#else
            for (int i = bx * NTHR + tid; i < M * D / 8; i += G * NTHR) ((v4u*)AO)[i] = (v4u){0u, 0u, 0u, 0u};
#endif
        }
#ifdef EXP_TWICE
        if (is_da && li == 0) {
            GRID_SYNC();
            { float d1 = wave_sum(P.in[8][lane] * P.in[9][lane]), d2 = wave_sum(P.in[10][lane] * P.in[11][lane]); const float lam_init = 0.8f - 0.6f * __expf(-0.3f * (float)li);
              att::da_phase(lds, QK, VT, (bf16*)(ws + WS_HB1), (float*)(ws + WS_KN), __expf(d1) - __expf(d2) + lam_init, 1.0f - lam_init, P.in[12], G, bx); }
            GRID_SYNC();
            { const v4u* a = (const v4u*)AO; const v4u* c = (const v4u*)(ws + WS_HB1); unsigned bad = 0;
              for (int i = bx * NTHR + tid; i < M * D / 8; i += G * NTHR) { const v4u u = a[i], w = c[i]; bad |= (u.x ^ w.x) | (u.y ^ w.y) | (u.z ^ w.z) | (u.w ^ w.w); }
              if (bad) __hip_atomic_store((unsigned*)(ws + WS_BAR + 128), 1u, __ATOMIC_RELAXED, __HIP_MEMORY_SCOPE_AGENT); }
        }
#endif
        { const f32x4* src = (const f32x4*)(pin + (size_t)li * M * PLE); v4u* dst = (v4u*)PB;
          const int str_ = G * NTHR;
          for (int i = bx * NTHR + tid; i < M * PLE / 8; i += 4 * str_) { f32x4 a[4], c[4];
#pragma unroll
              for (int k = 0; k < 4; ++k) { const int ii = min(i + k * str_, M * PLE / 8 - 1); a[k] = ((const __attribute__((address_space(1))) f32x4*)src)[2 * ii]; c[k] = ((const __attribute__((address_space(1))) f32x4*)src)[2 * ii + 1]; }
#pragma unroll
              for (int k = 0; k < 4; ++k) { const int ii = i + k * str_; if (ii < M * PLE / 8) { v4u w; w.x = pk2(a[k].x, a[k].y); w.y = pk2(a[k].z, a[k].w); w.z = pk2(c[k].x, c[k].y); w.w = pk2(c[k].z, c[k].w); ((__attribute__((address_space(1))) v4u*)dst)[ii] = w; } } } }
        }
        GRID_SYNC();
        { OPQ_TID(); OPQ_LAYER(); const float* x = P.in[0];
          pg8::Gemm g{AO, (const bf16*)(wl + WO_O), M, D, D}; pg8::StaticOrder S; S.init(M, D, G, bx);
          pg8::EpiResid E{HBc, HBc, ssq_ffn}; (void)x;
          GEMM_CALL_EpiResid(pg8::gemm_phase<pg8::EpiResid, pg8::StaticOrder, true, true>(lds, g, S, E)); }
        GRID_SYNC();
        { OPQ_TID(); OPQ_LAYER();
          pg8::Gemm g{HBc, (const bf16*)(wl + WO_GU), M, 2 * FF, D}; pg8::StaticOrder S; S.init(M, 2 * FF, G, bx);
          pg8::EpiSwiGLU E{HID, ssq_ffn};
          GEMM_CALL_EpiSwiGLU(pg8::gemm_phase<pg8::EpiSwiGLU, pg8::StaticOrder, true, true>(lds, g, S, E)); }
        { OPQ_TID(); OPQ_LAYER();
          pg8::Gemm g{PB, (const bf16*)(wl + WO_PP), M, D, PLE}; pg8::StaticOrder S; S.init(M, D, G, bx);
          pg8::EpiQK E{AO, D, nullptr, nullptr, 0, 1.f};
          GEMM_CALL_EpiQK(pg8::gemm_phase<pg8::EpiQK, pg8::StaticOrder, true, true>(lds, g, S, E)); }
        GRID_SYNC();
        { OPQ_TID(); OPQ_LAYER();
          pg8::Gemm g{HID, (const bf16*)(wl + WO_DN), M, D, FF}; pg8::StaticOrder S; S.init(M, D, G, bx);
          pg8::EpiResid E{HBc, HBc, ssq_ple};
          GEMM_CALL_EpiResid(pg8::gemm_phase<pg8::EpiResid, pg8::StaticOrder, true, true>(lds, g, S, E)); }
        GRID_SYNC();
        { OPQ_TID(); OPQ_LAYER();
          pg8::Gemm g{HBc, (const bf16*)(wl + WO_PG), M, D, D}; pg8::StaticOrder S; S.init(M, D, G, bx);
          pg8::EpiPle E{HBc, AO, HBn, ssq_ple, ssq_nxt};
          GEMM_CALL_EpiPle(pg8::gemm_phase<pg8::EpiPle, pg8::StaticOrder, true, true>(lds, g, S, E)); }
        GRID_SYNC();
    }
    {
        OPQ_TID(); OPQ_WS(); const float* norm_final = P.in[5];
        const pg8::u64* sq = ssq + (size_t)12 * M;
        typedef __attribute__((address_space(1))) f32x4 gf4; typedef __attribute__((address_space(1))) v2u gu2;
        const bf16* HBf = (const bf16*)(ws + ((DEPTH & 1) ? WS_HB1 : WS_HB0));
        f32x4 gg[4];
#pragma unroll
        for (int jj = 0; jj < 4; ++jj) gg[jj] = ((const gf4*)norm_final)[lane + 64 * jj];
        for (int m0 = gw; m0 < M; m0 += 4 * NGW) {
            v2u v[4][4]; pg8::u64 q4[4];
#pragma unroll
            for (int k = 0; k < 4; ++k) { const int m = m0 + k * NGW; q4[k] = ((const __attribute__((address_space(1))) pg8::u64*)sq)[m];
#pragma unroll
                for (int jj = 0; jj < 4; ++jj) v[k][jj] = ((const gu2*)(HBf + (size_t)m * D))[lane + 64 * jj]; }
#pragma unroll
            for (int k = 0; k < 4; ++k) { const int m = m0 + k * NGW; const float rs = pg8::rstd_of(q4[k]);
#pragma unroll
                for (int jj = 0; jj < 4; ++jj) { const v2u w = v[k][jj]; f32x4 f; f[0] = __uint_as_float(w.x << 16); f[1] = __uint_as_float(w.x & 0xffff0000u); f[2] = __uint_as_float(w.y << 16); f[3] = __uint_as_float(w.y & 0xffff0000u);
                    ((gf4*)(out + (size_t)m * D))[lane + 64 * jj] = f * rs * gg[jj]; } }
        }
        for (int m = M; m < M; ++m) { f32x4* hr = nullptr; (void)hr;
#ifdef EXP_TWICE
            if (__hip_atomic_load((unsigned*)(ws + WS_BAR + 128), __ATOMIC_RELAXED, __HIP_MEMORY_SCOPE_AGENT)) { const float qn = __builtin_nanf("");
                for (int jj = 0; jj < 4; ++jj) hr[64 * jj] = (f32x4){qn, qn, qn, qn}; }
#endif
        }
    }
}

extern "C" void kernel_launch(void* const* d_in, const int* in_sizes, int n_in, void* d_out, int out_size, void* d_ws, size_t ws_size, hipStream_t stream) {
    static int grid_blocks = 0;
    if (grid_blocks == 0) {
        if (n_in != 22 || out_size != M * D || ws_size < WS_END) { fprintf(stderr, "kernel_launch: unexpected shapes (n_in %d, out %d, ws %zu)\n", n_in, out_size, ws_size); grid_blocks = -1; return; }
        int dev = 0, cus = 0, per_cu = 0;
        hipGetDevice(&dev);
        hipDeviceGetAttribute(&cus, hipDeviceAttributeMultiprocessorCount, dev);
        if (hipFuncSetAttribute((const void*)fwd_megakernel, hipFuncAttributeMaxDynamicSharedMemorySize, LDS_BYTES) != hipSuccess) fprintf(stderr, "kernel_launch: hipFuncSetAttribute failed\n");
        if (hipOccupancyMaxActiveBlocksPerMultiprocessor(&per_cu, (const void*)fwd_megakernel, NTHR, LDS_BYTES) != hipSuccess || per_cu < 1) { fprintf(stderr, "kernel_launch: occupancy query gave %d\n", per_cu); per_cu = 1; }
        (void)hipGetLastError();
        grid_blocks = cus * per_cu;
    }
    if (grid_blocks < 0) return;
    if (hipMemsetAsync((char*)d_ws + WS_BAR, 0, 4096, stream) != hipSuccess) { fprintf(stderr, "kernel_launch: memset failed\n"); return; }
    Params p{};
    for (int i = 0; i < 22; ++i) p.in[i] = (const float*)d_in[i];
    p.out = (float*)d_out; p.ws = (unsigned char*)d_ws;
    void* args[] = {&p};
    hipError_t e = hipLaunchCooperativeKernel((const void*)fwd_megakernel, dim3(grid_blocks), dim3(NTHR), args, LDS_BYTES, stream);
    if (e != hipSuccess) fprintf(stderr, "cooperative launch failed: %s (grid %d)\n", hipGetErrorString(e), grid_blocks);
}
```

```cpp
#ifndef GQ
#define GQ(...) __VA_ARGS__
#endif
#ifndef GV
#define GV(...) __VA_ARGS__
#endif
#ifndef GR
#define GR(...) __VA_ARGS__
#endif
#ifndef GS
#define GS(...) __VA_ARGS__
#endif
#ifndef GP
#define GP(...) __VA_ARGS__
#endif
#define GEMM_CALL_EpiQK(...) GQ(__VA_ARGS__)
#define GEMM_CALL_EpiVT(...) GV(__VA_ARGS__)
#define GEMM_CALL_EpiResid(...) GR(__VA_ARGS__)
#define GEMM_CALL_EpiSwiGLU(...) GS(__VA_ARGS__)
#define GEMM_CALL_EpiPle(...) GP(__VA_ARGS__)
#include <hip/hip_runtime.h>
#include <hip/hip_cooperative_groups.h>
#include <cstdio>
#include <cstdint>
namespace cg = cooperative_groups;
namespace pg8 {
#define PG8_LAS __attribute__((address_space(3)))
typedef unsigned short bf16_t;
typedef short bf16x8 __attribute__((ext_vector_type(8)));
typedef float f32x4 __attribute__((ext_vector_type(4)));
typedef unsigned u32x4 __attribute__((ext_vector_type(4)));
constexpr int BM = 256, BK = 64, HALF = 128, HTB = HALF * BK * 2  , STAGE_BYTES = 8 * HTB, NXCD = 8, WGM = 8;

__host__ __device__ __forceinline__ int lds_byte(int r, int c) { const int st = (r >> 4) * 2 + (c >> 5), rr = r & 15, cc = c & 31, ob = rr * 64 + cc * 2; return st * 1024 + (ob ^ (((ob >> 9) & 1) << 5)); }
__host__ __device__ __forceinline__ void stage_rc(int b, int& R, int& C) { const int st = b / 1024, sb = b % 1024, swz = sb ^ (((sb >> 9) & 1) << 5); R = (st >> 1) * 16 + swz / 64; C = (st & 1) * 32 + (swz % 64) / 2; }
__host__ __device__ __forceinline__ int perm32(int rho) { const int n = rho >> 4, i = rho & 15; return 8 * (i >> 2) + 4 * n + (i & 3); }

struct Unit { int pm, pn; };
struct Gemm { const bf16_t* A; const bf16_t* Bt; int M, N, K; };

struct StaticOrder {
    int nM, nN, nwg, G, c;
    __host__ __device__ void init(int M, int N, int G_, int c_) { nM = M / BM; nN = N / BM; nwg = nM * nN; G = G_; c = c_; }
    __host__ __device__ bool next(int i, Unit& u) const {
        const long L = (long)i * G + c; if (L >= nwg) return false;
        int wgid = (int)L; { const int q = nwg / NXCD, r = nwg % NXCD, xcd = wgid % NXCD, off = wgid / NXCD; wgid = (xcd < r ? xcd * (q + 1) : r * (q + 1) + (xcd - r) * q) + off; }
        const int nig = WGM * nN, gid = wgid / nig, fm = gid * WGM, gsz = (nM - fm) < WGM ? (nM - fm) : WGM;
        u.pm = fm + ((wgid % nig) % gsz); u.pn = (wgid % nig) / gsz; return true;
    }
    __device__ __forceinline__ void a_ready(const Unit&) const {}
    __device__ __forceinline__ void done(const Unit&) const {}
};

__device__ __forceinline__ unsigned cvt_pk_bf16(float lo, float hi) { unsigned r; asm volatile("v_cvt_pk_bf16_f32 %0, %1, %2" : "=v"(r) : "v"(lo), "v"(hi)); return r; }
typedef float f32x2 __attribute__((ext_vector_type(2)));
typedef unsigned u32x2 __attribute__((ext_vector_type(2)));
#define PG8_GAS __attribute__((address_space(1)))
constexpr float LOG2E = 1.4426950408889634f;
typedef unsigned long long u64;
constexpr float SSQ_FIX = 1048576.0f;
__device__ __forceinline__ float rstd_of(u64 q) { return rsqrtf((float)q * (1.0f / (SSQ_FIX * 1024.0f)) + 1e-6f); }
__device__ __forceinline__ float rstd_row(const u64* ssq, int row) { return rstd_of(((const PG8_GAS u64*)ssq)[row]); }
__device__ __forceinline__ float sigm(float a) { return __builtin_amdgcn_rcpf(1.0f + __builtin_amdgcn_exp2f(-a * LOG2E)); }
__device__ __forceinline__ void atomic_addf(u64* p, float v) { __hip_atomic_fetch_add((PG8_GAS u64*)p, (u64)(v * SSQ_FIX + 0.5f), __ATOMIC_RELAXED, __HIP_MEMORY_SCOPE_AGENT); }

struct EpiQK {
    static constexpr bool PERM = true, AFTER_DRAIN = false;
    bf16_t* O; int ldc; const u64* ssq; const float* bias; int qcols; float qscale;
    __device__ __forceinline__ void operator()(const f32x4 (&acc)[2][2][4][2], const Unit& u, int wr, int wc, int fr, int fq) const {
        const int row0 = u.pm * BM + wr * 64 + fr, col0 = u.pn * BM + wc * 32 + 8 * fq;
        const float sc = (u.pn * BM < qcols) ? qscale : 1.f;
        f32x4 bv[2][2];
#pragma unroll
        for (int bj = 0; bj < 2; ++bj)
#pragma unroll
            for (int n = 0; n < 2; ++n) bv[bj][n] = bias ? *(const PG8_GAS f32x4*)(bias + col0 + bj * HALF + 4 * n) : (f32x4){0.f, 0.f, 0.f, 0.f};
#pragma unroll
        for (int ai = 0; ai < 2; ++ai)
#pragma unroll
            for (int m = 0; m < 4; ++m) { const int row = row0 + ai * HALF + m * 16; const float rs = ssq ? rstd_row(ssq, row) : 1.f; bf16_t* rowp = O + (size_t)row * ldc + col0;
#pragma unroll
                for (int bj = 0; bj < 2; ++bj) { const f32x4 v0 = (acc[ai][bj][m][0] * rs + bv[bj][0]) * sc, v1 = (acc[ai][bj][m][1] * rs + bv[bj][1]) * sc;
                    u32x4 w; w.x = cvt_pk_bf16(v0[0], v0[1]); w.y = cvt_pk_bf16(v0[2], v0[3]); w.z = cvt_pk_bf16(v1[0], v1[1]); w.w = cvt_pk_bf16(v1[2], v1[3]);
                    *(PG8_GAS u32x4*)(rowp + bj * HALF) = w; } }
    }
};
struct EpiVT {
    static constexpr bool PERM = true, AFTER_DRAIN = false;
    bf16_t* O; int ldc; const u64* ssq; const float* bias;
    __device__ __forceinline__ void operator()(const f32x4 (&acc)[2][2][4][2], const Unit& u, int wr, int wc, int fr, int fq) const {
        const int row0 = u.pm * BM + wr * 64 + fr, col0 = u.pn * BM + wc * 32 + 8 * fq;
        f32x4 rs[2][2];
#pragma unroll
        for (int bj = 0; bj < 2; ++bj)
#pragma unroll
            for (int n = 0; n < 2; ++n) {
#pragma unroll
                for (int i = 0; i < 4; ++i) rs[bj][n][i] = rstd_of(((const PG8_GAS u64*)ssq)[col0 + bj * HALF + 4 * n + i]); }
#pragma unroll
        for (int ai = 0; ai < 2; ++ai)
#pragma unroll
            for (int m = 0; m < 4; ++m) { const int row = row0 + ai * HALF + m * 16; const float bb = bias ? ((const PG8_GAS float*)bias)[row] : 0.f; bf16_t* rowp = O + (size_t)row * ldc + col0;
#pragma unroll
                for (int bj = 0; bj < 2; ++bj) { const f32x4 v0 = acc[ai][bj][m][0] * rs[bj][0] + bb, v1 = acc[ai][bj][m][1] * rs[bj][1] + bb;
                    u32x4 w; w.x = cvt_pk_bf16(v0[0], v0[1]); w.y = cvt_pk_bf16(v0[2], v0[3]); w.z = cvt_pk_bf16(v1[0], v1[1]); w.w = cvt_pk_bf16(v1[2], v1[3]);
                    *(PG8_GAS u32x4*)(rowp + bj * HALF) = w; } }
    }
};
struct EpiResid {
    static constexpr bool PERM = true, AFTER_DRAIN = false;
    const bf16_t* base; bf16_t* hb; u64* ssq_next;
    __device__ __forceinline__ void operator()(const f32x4 (&acc)[2][2][4][2], const Unit& u, int wr, int wc, int fr, int fq) const {
        const int row0 = u.pm * BM + wr * 64 + fr, col0 = u.pn * BM + wc * 32 + 8 * fq;
#pragma unroll
        for (int ai = 0; ai < 2; ++ai) {
            u32x4 bs[4][2];
#pragma unroll
            for (int m = 0; m < 4; ++m) { const size_t off0 = (size_t)(row0 + ai * HALF + m * 16) * 1024 + col0;
#pragma unroll
                for (int bj = 0; bj < 2; ++bj) bs[m][bj] = *(const PG8_GAS u32x4*)(base + off0 + bj * HALF); }
            asm volatile("" ::: "memory");
#pragma unroll
            for (int m = 0; m < 4; ++m) { const int row = row0 + ai * HALF + m * 16; const size_t off0 = (size_t)row * 1024 + col0; float ss = 0.f;
#pragma unroll
                for (int bj = 0; bj < 2; ++bj) { const u32x4 bw = bs[m][bj]; f32x4 v0 = acc[ai][bj][m][0], v1 = acc[ai][bj][m][1];
                    v0[0] += __uint_as_float(bw.x << 16); v0[1] += __uint_as_float(bw.x & 0xffff0000u); v0[2] += __uint_as_float(bw.y << 16); v0[3] += __uint_as_float(bw.y & 0xffff0000u);
                    v1[0] += __uint_as_float(bw.z << 16); v1[1] += __uint_as_float(bw.z & 0xffff0000u); v1[2] += __uint_as_float(bw.w << 16); v1[3] += __uint_as_float(bw.w & 0xffff0000u);
                    u32x4 w; w.x = cvt_pk_bf16(v0[0], v0[1]); w.y = cvt_pk_bf16(v0[2], v0[3]); w.z = cvt_pk_bf16(v1[0], v1[1]); w.w = cvt_pk_bf16(v1[2], v1[3]);
                    *(PG8_GAS u32x4*)(hb + off0 + bj * HALF) = w;
                    ss += ((v0[0] * v0[0] + v0[1] * v0[1]) + (v0[2] * v0[2] + v0[3] * v0[3])) + ((v1[0] * v1[0] + v1[1] * v1[1]) + (v1[2] * v1[2] + v1[3] * v1[3])); }
                ss += __shfl_xor(ss, 16); ss += __shfl_xor(ss, 32);
                if (fq == 0) atomic_addf(ssq_next + row, ss); }
            asm volatile("" ::: "memory");
        }
    }
};
struct EpiSwiGLU {
    static constexpr bool PERM = true, AFTER_DRAIN = false;
    bf16_t* O; const u64* ssq;
    __device__ __forceinline__ void operator()(const f32x4 (&acc)[2][2][4][2], const Unit& u, int wr, int wc, int fr, int fq) const {
        const int row0 = u.pm * BM + wr * 64 + fr, colh = u.pn * HALF + wc * 32 + 8 * fq;
#pragma unroll
        for (int ai = 0; ai < 2; ++ai)
#pragma unroll
            for (int m = 0; m < 4; ++m) { const int row = row0 + ai * HALF + m * 16; const float rs = rstd_row(ssq, row); f32x4 r[2];
#pragma unroll
                for (int n = 0; n < 2; ++n) { const f32x4 g = acc[ai][0][m][n] * rs, up = acc[ai][1][m][n] * rs;
#pragma unroll
                    for (int i = 0; i < 4; ++i) r[n][i] = g[i] * sigm(g[i]) * up[i]; }
                u32x4 w; w.x = cvt_pk_bf16(r[0][0], r[0][1]); w.y = cvt_pk_bf16(r[0][2], r[0][3]); w.z = cvt_pk_bf16(r[1][0], r[1][1]); w.w = cvt_pk_bf16(r[1][2], r[1][3]);
                *(PG8_GAS u32x4*)(O + (size_t)row * 2816 + colh) = w; }
    }
};
struct EpiPle {
    static constexpr bool PERM = true, AFTER_DRAIN = false;
    const bf16_t* hin; const bf16_t* proj; bf16_t* hb; const u64* ssq_in; u64* ssq_next;
    __device__ __forceinline__ void operator()(const f32x4 (&acc)[2][2][4][2], const Unit& u, int wr, int wc, int fr, int fq) const {
        const int row0 = u.pm * BM + wr * 64 + fr, col0 = u.pn * BM + wc * 32 + 8 * fq;
#pragma unroll
        for (int ai = 0; ai < 2; ++ai) {
            u32x4 hs[4][2], ps[4][2]; u64 sq[4];
#pragma unroll
            for (int m = 0; m < 4; ++m) { const int row = row0 + ai * HALF + m * 16; const size_t off0 = (size_t)row * 1024 + col0; sq[m] = ((const PG8_GAS u64*)ssq_in)[row];
#pragma unroll
                for (int bj = 0; bj < 2; ++bj) { hs[m][bj] = *(const PG8_GAS u32x4*)(hin + off0 + bj * HALF); ps[m][bj] = *(const PG8_GAS u32x4*)(proj + off0 + bj * HALF); } }
            asm volatile("" ::: "memory");
#pragma unroll
            for (int m = 0; m < 4; ++m) { const int row = row0 + ai * HALF + m * 16; const size_t off0 = (size_t)row * 1024 + col0; const float rs = rstd_of(sq[m]); float ss = 0.f;
#pragma unroll
                for (int bj = 0; bj < 2; ++bj) { const u32x4 pw = ps[m][bj], hw = hs[m][bj]; u32x4 w;
#pragma unroll
                    for (int n = 0; n < 2; ++n) { const f32x4 a = acc[ai][bj][m][n] * rs; const unsigned p0 = n ? pw.z : pw.x, p1 = n ? pw.w : pw.y, h0 = n ? hw.z : hw.x, h1 = n ? hw.w : hw.y;
                        f32x4 v; v[0] = __uint_as_float(h0 << 16) + sigm(a[0]) * __uint_as_float(p0 << 16); v[1] = __uint_as_float(h0 & 0xffff0000u) + sigm(a[1]) * __uint_as_float(p0 & 0xffff0000u);
                        v[2] = __uint_as_float(h1 << 16) + sigm(a[2]) * __uint_as_float(p1 << 16); v[3] = __uint_as_float(h1 & 0xffff0000u) + sigm(a[3]) * __uint_as_float(p1 & 0xffff0000u);
                        const unsigned c0 = cvt_pk_bf16(v[0], v[1]), c1 = cvt_pk_bf16(v[2], v[3]); if (n) { w.z = c0; w.w = c1; } else { w.x = c0; w.y = c1; }
                        ss += (v[0] * v[0] + v[1] * v[1]) + (v[2] * v[2] + v[3] * v[3]); }
                    *(PG8_GAS u32x4*)(hb + off0 + bj * HALF) = w; }
                ss += __shfl_xor(ss, 16); ss += __shfl_xor(ss, 32);
                if (fq == 0) atomic_addf(ssq_next + row, ss); }
            asm volatile("" ::: "memory");
        }
    }
};
template <class Epi, class Sched, bool ALIGN_EPI = false, bool SP2 = false>
__device__ __forceinline__ void gemm_phase(PG8_LAS unsigned char* lds, const Gemm g, const Sched& S, const Epi& E) {
    int tid_ = threadIdx.x; asm volatile("" : "+v"(tid_));
    const int tid = tid_, wid = __builtin_amdgcn_readfirstlane(tid >> 6), lane = tid & 63, wr = wid >> 2, wc = wid & 3, fr = lane & 15, fq = lane >> 4;
    const int K = g.K, nt = K / BK;
    unsigned voffA[2], voffB[2];
#pragma unroll
    for (int i = 0; i < 2; ++i) { int R, C; stage_rc(tid * 16 + i * 8192, R, C); const int Rb = Epi::PERM ? ((R & ~31) + perm32(R & 31)) : R;
        voffA[i] = (unsigned)(R * K + C) * 2u; voffB[i] = (unsigned)(Rb * K + C) * 2u; }
    const size_t kstep = (size_t)(BK * 2);
    const size_t hstep = (size_t)HALF * K * 2;
    const size_t tstep = 2 * hstep;
    const unsigned ldsw = (unsigned)wid * 1024u;
    const int aoff = lds_byte(wr * 64 + fr, fq * 8), boff = lds_byte(wc * 32 + fr, fq * 8);
#define PG8_SA(b, h) (((b) * 2 + (h)) * HTB)
#define PG8_SB(b, h) ((4 + (b) * 2 + (h)) * HTB)
#define PG8_STAGE(bufoff, gbase, voff) do { _Pragma("unroll") for (int _i = 0; _i < 2; ++_i) \
        __builtin_amdgcn_global_load_lds((const unsigned*)((const char*)(gbase) + (voff)[_i]), (PG8_LAS unsigned*)(lds + (bufoff) + ldsw + _i * 8192), 16, 0, 0); } while (0)
#define PG8_LDA(dst, b, h) do { _Pragma("unroll") for (int m = 0; m < 4; ++m) _Pragma("unroll") for (int k = 0; k < 2; ++k) dst[m][k] = *(const PG8_LAS bf16x8*)(lds + PG8_SA(b, h) + aoff + m * 2048 + k * 1024); } while (0)
#define PG8_LDB(dst, b, h) do { _Pragma("unroll") for (int n = 0; n < 2; ++n) _Pragma("unroll") for (int k = 0; k < 2; ++k) dst[n][k] = *(const PG8_LAS bf16x8*)(lds + PG8_SB(b, h) + boff + n * 2048 + k * 1024); } while (0)
#define PG8_MMA(ai, bj, At, Bt) do { __builtin_amdgcn_s_setprio(1); _Pragma("unroll") for (int m = 0; m < 4; ++m) _Pragma("unroll") for (int n = 0; n < 2; ++n) _Pragma("unroll") for (int k = 0; k < 2; ++k) \
        acc[ai][bj][m][n] = __builtin_amdgcn_mfma_f32_16x16x32_bf16(Bt[n][k], At[m][k], acc[ai][bj][m][n], 0, 0, 0); __builtin_amdgcn_s_setprio(0); } while (0)
#define PG8_WAIT_V(n) asm volatile("s_waitcnt vmcnt(" #n ")" ::: "memory")
#define PG8_WAIT_L(n) asm volatile("s_waitcnt lgkmcnt(" #n ")" ::: "memory")
#define PG8_BAR __builtin_amdgcn_s_barrier()
#define PG8_SCHED __builtin_amdgcn_sched_barrier(0)
    Unit cur, nxt; int ui = 0;
    if (!S.next(0, cur)) return;
    f32x4 acc[2][2][4][2];
#pragma unroll
    for (int a = 0; a < 2; ++a)
#pragma unroll
        for (int b = 0; b < 2; ++b)
#pragma unroll
            for (int m = 0; m < 4; ++m)
#pragma unroll
                for (int n = 0; n < 2; ++n) acc[a][b][m][n] = (f32x4){0.f, 0.f, 0.f, 0.f};
    bf16x8 At[4][2], B0[2][2], B1[2][2];
    const char* cA = (const char*)g.A + (size_t)cur.pm * tstep; const char* cB = (const char*)g.Bt + (size_t)cur.pn * tstep;
    S.a_ready(cur);
    if constexpr (SP2) {
        PG8_STAGE(PG8_SB(0, 0), cB, voffB); PG8_STAGE(PG8_SB(0, 1), cB + hstep, voffB); PG8_STAGE(PG8_SA(0, 0), cA, voffA); PG8_STAGE(PG8_SA(0, 1), cA + hstep, voffA);
        if (wr == 1) PG8_BAR;
        PG8_WAIT_V(2); PG8_BAR;
        PG8_STAGE(PG8_SB(1, 0), cB + kstep, voffB); PG8_STAGE(PG8_SA(1, 0), cA + kstep, voffA); PG8_STAGE(PG8_SB(1, 1), cB + hstep + kstep, voffB);
        PG8_WAIT_V(6); PG8_BAR;
    } else {
        PG8_STAGE(PG8_SB(0, 0), cB, voffB); PG8_STAGE(PG8_SA(0, 0), cA, voffA); PG8_STAGE(PG8_SB(0, 1), cB + hstep, voffB); PG8_STAGE(PG8_SA(0, 1), cA + hstep, voffA);
        if (wr == 1) PG8_BAR;
        PG8_WAIT_V(4); PG8_BAR;
        PG8_STAGE(PG8_SB(1, 0), cB + kstep, voffB); PG8_STAGE(PG8_SA(1, 0), cA + kstep, voffA); PG8_STAGE(PG8_SB(1, 1), cB + hstep + kstep, voffB);
        PG8_WAIT_V(6); PG8_BAR;
    }
    for (;;) {
        const bool has_next = S.next(ui + 1, nxt);
        const char* nA = has_next ? (const char*)g.A + (size_t)nxt.pm * tstep : cA; const char* nB = has_next ? (const char*)g.Bt + (size_t)nxt.pn * tstep : cB;
        for (int t = 0; t < nt; t += 2) {
            const bool last = (t == nt - 2);
            const char* a1 = cA + (size_t)(t + 1) * kstep;
            const char* a2 = last ? nA : cA + (size_t)(t + 2) * kstep; const char* b2 = last ? nB : cB + (size_t)(t + 2) * kstep;
            const char* a3 = a2 + kstep; const char* b3 = b2 + kstep;
            if (last && has_next) S.a_ready(nxt);
            if constexpr (SP2) {
            PG8_LDB(B0, 0, 0); PG8_LDB(B1, 0, 1); PG8_SCHED; PG8_LDA(At, 0, 0); PG8_STAGE(PG8_SA(1, 1), a1 + hstep, voffA);
            PG8_WAIT_V(8); PG8_WAIT_L(0); PG8_BAR; PG8_MMA(0, 0, At, B0); PG8_MMA(0, 1, At, B1); PG8_BAR; PG8_SCHED;
            PG8_LDA(At, 0, 1); PG8_STAGE(PG8_SB(0, 0), b2, voffB); PG8_STAGE(PG8_SB(0, 1), b2 + hstep, voffB); PG8_STAGE(PG8_SA(0, 0), a2, voffA);
            PG8_WAIT_V(8); PG8_WAIT_L(0); PG8_BAR; PG8_MMA(1, 0, At, B0); PG8_MMA(1, 1, At, B1); PG8_BAR; PG8_SCHED;
            PG8_LDB(B0, 1, 0); PG8_LDB(B1, 1, 1); PG8_SCHED; PG8_LDA(At, 1, 0); PG8_STAGE(PG8_SA(0, 1), a2 + hstep, voffA);
            PG8_WAIT_V(8); PG8_WAIT_L(0); PG8_BAR; PG8_MMA(0, 0, At, B0); PG8_MMA(0, 1, At, B1); PG8_BAR; PG8_SCHED;
            PG8_LDA(At, 1, 1); PG8_STAGE(PG8_SB(1, 0), b3, voffB); PG8_STAGE(PG8_SB(1, 1), b3 + hstep, voffB); PG8_STAGE(PG8_SA(1, 0), a3, voffA);
            PG8_WAIT_V(8); PG8_WAIT_L(0); PG8_BAR; PG8_MMA(1, 0, At, B0); PG8_MMA(1, 1, At, B1); PG8_BAR; PG8_SCHED;
            } else {
            PG8_LDB(B0, 0, 0); PG8_SCHED; PG8_LDA(At, 0, 0); PG8_STAGE(PG8_SA(1, 1), a1 + hstep, voffA);
            PG8_WAIT_L(8); PG8_BAR; PG8_WAIT_L(0); PG8_MMA(0, 0, At, B0); PG8_BAR; PG8_SCHED;
            PG8_LDB(B1, 0, 1); PG8_STAGE(PG8_SB(0, 0), b2, voffB);
            PG8_BAR; PG8_WAIT_L(0); PG8_MMA(0, 1, At, B1); PG8_BAR;
            PG8_LDA(At, 0, 1); PG8_STAGE(PG8_SA(0, 0), a2, voffA);
            PG8_BAR; PG8_WAIT_L(0); PG8_MMA(1, 0, At, B0); PG8_BAR; PG8_SCHED;
            PG8_STAGE(PG8_SB(0, 1), b2 + hstep, voffB);
            PG8_WAIT_V(6); PG8_BAR; PG8_MMA(1, 1, At, B1); PG8_BAR;
            PG8_LDB(B0, 1, 0); PG8_SCHED; PG8_LDA(At, 1, 0); PG8_STAGE(PG8_SA(0, 1), a2 + hstep, voffA);
            PG8_WAIT_L(8); PG8_BAR; PG8_WAIT_L(0); PG8_MMA(0, 0, At, B0); PG8_BAR; PG8_SCHED;
            PG8_LDB(B1, 1, 1); PG8_STAGE(PG8_SB(1, 0), b3, voffB);
            PG8_BAR; PG8_WAIT_L(0); PG8_MMA(0, 1, At, B1); PG8_BAR;
            PG8_LDA(At, 1, 1); PG8_STAGE(PG8_SA(1, 0), a3, voffA);
            PG8_BAR; PG8_WAIT_L(0); PG8_MMA(1, 0, At, B0); PG8_BAR; PG8_SCHED;
            PG8_STAGE(PG8_SB(1, 1), b3 + hstep, voffB);
            PG8_WAIT_V(6); PG8_BAR; PG8_MMA(1, 1, At, B1); PG8_BAR;
            }
        }
        if constexpr (ALIGN_EPI) { if (wr == 0) PG8_BAR; }
        if constexpr (!Epi::AFTER_DRAIN) { E(acc, cur, wr, wc, fr, fq); S.done(cur); }
        if (!has_next) break;
#pragma unroll
        for (int a = 0; a < 2; ++a)
#pragma unroll
            for (int b = 0; b < 2; ++b)
#pragma unroll
                for (int m = 0; m < 4; ++m)
#pragma unroll
                    for (int n = 0; n < 2; ++n) acc[a][b][m][n] = (f32x4){0.f, 0.f, 0.f, 0.f};
        cur = nxt; cA = nA; cB = nB; ++ui;
        if constexpr (ALIGN_EPI) { if (wr == 1) PG8_BAR; }
    }
    PG8_WAIT_V(0);
    if constexpr (!ALIGN_EPI) { if (wr == 0) PG8_BAR; }
    PG8_BAR;
    if constexpr (Epi::AFTER_DRAIN) { E.fused(acc, cur, wr, wc, fr, fq, lds, wid, lane); S.done(cur); }
#undef PG8_SA
#undef PG8_SB
#undef PG8_STAGE
#undef PG8_LDA
#undef PG8_LDB
#undef PG8_MMA
#undef PG8_WAIT_V
#undef PG8_WAIT_L
#undef PG8_BAR
#undef PG8_SCHED
}
}
namespace att {
#define LAS __attribute__((address_space(3)))
typedef unsigned short bf16_t;
typedef short bf16x8 __attribute__((ext_vector_type(8)));
typedef float f32x4 __attribute__((ext_vector_type(4)));
typedef float f32x16 __attribute__((ext_vector_type(16)));
typedef unsigned u32x4 __attribute__((ext_vector_type(4)));
typedef unsigned u32x2 __attribute__((ext_vector_type(2)));
typedef float f32x2_t __attribute__((ext_vector_type(2))); typedef __bf16 bf16x2_t __attribute__((ext_vector_type(2)));
constexpr float LOG2E = 1.4426950408889634f;
constexpr int SEQ = 4096, MTOK = 65536;
__device__ __forceinline__ unsigned cvtpk(float lo, float hi) { f32x2_t v = {lo, hi}; bf16x2_t b = __builtin_convertvector(v, bf16x2_t); return __builtin_bit_cast(unsigned, b); }

#define GAS __attribute__((address_space(1)))
__device__ __forceinline__ void da_knorm(const bf16_t* QK_, float* kn_, int gw, int NGW, int lane) {
    const GAS bf16_t* QK = (const GAS bf16_t*)QK_; GAS float* kn = (GAS float*)kn_;
    for (int task = gw; task < 16 * 8 * 64; task += NGW) {
        const int b = task >> 9, h = (task >> 6) & 7, t = task & 63;
        const GAS u32x4* p = (const GAS u32x4*)(QK + ((size_t)b * SEQ + t * 64 + lane) * 2048 + 1024 + h * 128);
        float a[2] = {0.f, 0.f};
#pragma unroll
        for (int c = 0; c < 16; ++c) { const u32x4 w = p[c];
#pragma unroll
            for (int i = 0; i < 4; ++i) { const float lo = __uint_as_float(w[i] << 16), hi = __uint_as_float(w[i] & 0xffff0000u); a[c >> 3] += lo * lo + hi * hi; } }
        float m = __builtin_fmaxf(a[0], a[1]);
#pragma unroll
        for (int o = 1; o < 64; o <<= 1) m = __builtin_fmaxf(m, __shfl_xor(m, o));
        if (lane == 0) kn[task] = __builtin_sqrtf(m) * 1.002f;
    }
}
__device__ __forceinline__ void da_phase(LAS unsigned char* lds, const bf16_t* QK_, const bf16_t* VT_, bf16_t* AO_, const float* kn_,
                                         float lam, float outscale, const float* subln_, int G, int bx) {
    int tid_ = threadIdx.x; asm volatile("" : "+v"(tid_));
    const int tid = tid_, lane = tid & 63, wid = __builtin_amdgcn_readfirstlane(tid >> 6), q = lane & 31, hi = lane >> 5, mp = wid >> 2, wq = wid & 3;
    const GAS bf16_t* QK = (const GAS bf16_t*)QK_; const GAS bf16_t* VT = (const GAS bf16_t*)VT_; GAS bf16_t* AO = (GAS bf16_t*)AO_; const GAS float* kn = (const GAS float*)kn_; const GAS float* subln = (const GAS float*)subln_;
    const int pi = (q & ~12) | ((q & 8) >> 1) | ((q & 4) << 1);
    unsigned rk[4], rv[4];
#pragma unroll
    for (int s = 0; s < 4; ++s) { const int ck = 2 * s + hi; rk[s] = mp * 8192 + ck * 1024 + (pi ^ ck) * 16; }
#pragma unroll
    for (int jv = 0; jv < 4; ++jv) { const int cv = 2 * jv + hi; rv[jv] = 16384 + cv * 2048 + (q ^ cv) * 16; }
    const int kr = tid >> 4, kch = tid & 15, vd = tid >> 3, vc = tid & 7;
    const unsigned kdst = (kch >> 3) * 8192 + (kch & 7) * 1024 + (kr ^ (kch & 7)) * 16, vdst = 16384 + vc * 2048 + (vd ^ vc) * 16;
    LAS float* xch = (LAS float*)(lds + 65536) + wq * 4096 + lane;
    LAS float* red = (LAS float*)(lds + 131072);
    for (int un = bx; un < 4096; un += G) {
        int b, h, qb; if (G == 256) { const int k = un >> 8; b = k; h = (bx + k) & 7; qb = ((bx >> 3) + 16 * (k & 1)) & 31; } else { b = un >> 8; h = (un >> 5) & 7; qb = un & 31; }
        const float nslope2 = -__builtin_amdgcn_exp2f(-(float)(h + 1)) * LOG2E;
        const size_t tokb = (size_t)b * SEQ;
        const int qpos = qb * 128 + wq * 32 + q;
        const GAS bf16_t* ksrc = QK + (tokb + kr) * 2048 + 1024 + h * 128 + kch * 8;
        const GAS bf16_t* vsrc = VT + (size_t)(h * 128 + vd) * MTOK + tokb + vc * 8;
        u32x4 sa0, sa1, sa2, sa3, sb0, sb1, sb2, sb3;
#define DA_LOADT(S, t) do { S##0 = *(const GAS u32x4*)(ksrc + (size_t)(t) * 64 * 2048); S##1 = *(const GAS u32x4*)(ksrc + (size_t)(t) * 64 * 2048 + 32 * 2048); \
                         S##2 = *(const GAS u32x4*)(vsrc + (t) * 64); S##3 = *(const GAS u32x4*)(vsrc + (size_t)64 * MTOK + (t) * 64); } while (0)
#define DA_STORET(S, bo) do { *(LAS u32x4*)(lds + (bo) + kdst) = S##0; *(LAS u32x4*)(lds + (bo) + kdst + 512) = S##1; *(LAS u32x4*)(lds + (bo) + vdst) = S##2; *(LAS u32x4*)(lds + (bo) + vdst + 1024) = S##3; } while (0)
        const int d0 = 2 * qb, d1 = 2 * qb + 1;
        DA_LOADT(sa, d0); DA_LOADT(sb, d1);
        bf16x8 qf[4]; float qn2 = 0.f;
        { const GAS bf16_t* qp = QK + (tokb + qpos) * 2048 + h * 128 + mp * 64 + 8 * hi;
#pragma unroll
          for (int s = 0; s < 4; ++s) { qf[s] = *(const GAS bf16x8*)(qp + 16 * s);
#pragma unroll
              for (int i = 0; i < 8; ++i) { const float v = __uint_as_float(((unsigned)(unsigned short)qf[s][i]) << 16); qn2 += v * v; } } }
        qn2 += __shfl_xor(qn2, 32);
        const float knl = kn[(b * 8 + h) * 64 + lane];
        f32x16 o[4];
#pragma unroll
        for (int d = 0; d < 4; ++d) o[d] = f32x16{};
        float mref = 0.f, l = 0.f;
#define DA_COMPUTE(t, bo, FIRST, LIN) do { \
            f32x16 p[2]; \
            const float dbase = (float)((t) * 64 + 8 * hi - qpos); \
            const float sg_ = ((t) < d0) ? -nslope2 : nslope2, A_ = dbase * sg_ - mref;     \
            _Pragma("unroll") for (int hf = 0; hf < 2; ++hf) { \
                if (LIN) { _Pragma("unroll") for (int r = 0; r < 16; ++r) p[hf][r] = __builtin_fmaf((float)(32 * hf + 16 * (r >> 3) + (r & 7)), sg_, A_); } \
                else { _Pragma("unroll") for (int r = 0; r < 16; ++r) p[hf][r] = __builtin_fmaf(__builtin_fabsf(dbase + (float)(32 * hf + 16 * (r >> 3) + (r & 7))), nslope2, -mref); } } \
              \
            _Pragma("unroll") for (int s = 0; s < 4; ++s) _Pragma("unroll") for (int hf = 0; hf < 2; ++hf) { \
                const bf16x8 kf = *(const LAS bf16x8*)(lds + (bo) + rk[s] + hf * 512); p[hf] = __builtin_amdgcn_mfma_f32_32x32x16_bf16(kf, qf[s], p[hf], 0, 0, 0); } \
            float mx = p[0][0]; \
            _Pragma("unroll") for (int r = 1; r < 16; ++r) mx = __builtin_fmaxf(mx, p[0][r]); \
            _Pragma("unroll") for (int r = 0; r < 16; ++r) mx = __builtin_fmaxf(mx, p[1][r]); \
            mx = __builtin_fmaxf(mx, __shfl_xor(mx, 32)); \
              \
            if (!(FIRST) && !__any(mx > -36.0f)) break; \
            if (FIRST) { mref = mx; \
                _Pragma("unroll") for (int r = 0; r < 16; ++r) { p[0][r] -= mx; p[1][r] -= mx; } } \
            else if (__any(mx > 8.0f)) { const float dl = __builtin_fmaxf(mx, 0.f); mref += dl; const float f = __builtin_amdgcn_exp2f(-dl); l *= f; \
                _Pragma("unroll") for (int r = 0; r < 16; ++r) { p[0][r] -= dl; p[1][r] -= dl; } \
                _Pragma("unroll") for (int d = 0; d < 4; ++d) _Pragma("unroll") for (int r = 0; r < 16; ++r) o[d][r] *= f; } \
              \
            float sacc = 0.f; bf16x8 pf[2][2]; \
            _Pragma("unroll") for (int r = 0; r < 16; ++r) { p[0][r] = __builtin_amdgcn_exp2f(p[0][r]); sacc += p[0][r]; } \
            _Pragma("unroll") for (int u = 0; u < 2; ++u) { u32x4 w; w.x = cvtpk(p[0][8 * u], p[0][8 * u + 1]); w.y = cvtpk(p[0][8 * u + 2], p[0][8 * u + 3]); \
                    w.z = cvtpk(p[0][8 * u + 4], p[0][8 * u + 5]); w.w = cvtpk(p[0][8 * u + 6], p[0][8 * u + 7]); pf[0][u] = __builtin_bit_cast(bf16x8, w); } \
            _Pragma("unroll") for (int u = 0; u < 2; ++u) _Pragma("unroll") for (int d = 0; d < 4; ++d) { \
                    const bf16x8 vf = *(const LAS bf16x8*)(lds + (bo) + rv[u] + d * 512); o[d] = __builtin_amdgcn_mfma_f32_32x32x16_bf16(vf, pf[0][u], o[d], 0, 0, 0); } \
            _Pragma("unroll") for (int r = 0; r < 16; ++r) { p[1][r] = __builtin_amdgcn_exp2f(p[1][r]); sacc += p[1][r]; } \
            _Pragma("unroll") for (int u = 0; u < 2; ++u) { u32x4 w; w.x = cvtpk(p[1][8 * u], p[1][8 * u + 1]); w.y = cvtpk(p[1][8 * u + 2], p[1][8 * u + 3]); \
                    w.z = cvtpk(p[1][8 * u + 4], p[1][8 * u + 5]); w.w = cvtpk(p[1][8 * u + 6], p[1][8 * u + 7]); pf[1][u] = __builtin_bit_cast(bf16x8, w); } \
            _Pragma("unroll") for (int i_ = 0; i_ < 8; ++i_) { __builtin_amdgcn_sched_group_barrier(0x100, 1, 0); __builtin_amdgcn_sched_group_barrier(0x008, 1, 0); __builtin_amdgcn_sched_group_barrier(0x002, 5, 0); } \
            l += sacc; \
            _Pragma("unroll") for (int u = 0; u < 2; ++u) _Pragma("unroll") for (int d = 0; d < 4; ++d) { \
                    const bf16x8 vf = *(const LAS bf16x8*)(lds + (bo) + rv[2 + u] + d * 512); o[d] = __builtin_amdgcn_mfma_f32_32x32x16_bf16(vf, pf[1][u], o[d], 0, 0, 0); } \
        } while (0)
        DA_STORET(sa, 0);
        __syncthreads();
        DA_COMPUTE(d0, 0, true, false);
        DA_STORET(sb, 32768);
        __syncthreads();
        DA_COMPUTE(d1, 32768, false, false);
        { float lmin = mref, qmx = qn2;
#pragma unroll
          for (int o_ = 1; o_ < 64; o_ <<= 1) { lmin = __builtin_fminf(lmin, __shfl_xor(lmin, o_)); qmx = __builtin_fmaxf(qmx, __shfl_xor(qmx, o_)); }
          if (lane == 0) { red[2 * wid] = lmin; red[2 * wid + 1] = qmx; } }
        __syncthreads();
        unsigned long long mask;
        { float Lmin = red[0], Q2 = red[1];
#pragma unroll
          for (int w = 1; w < 8; ++w) { Lmin = __builtin_fminf(Lmin, red[2 * w]); Q2 = __builtin_fmaxf(Q2, red[2 * w + 1]); }
          const float Qmax = __builtin_sqrtf(Q2) * 1.002f;
          const int t = lane, mind = (t < d0) ? (qb * 128 - (t * 64 + 63)) : (t * 64 - (qb * 128 + 127));
          const float bound = Qmax * knl + nslope2 * (float)mind;
          const bool need = (t != d0) && (t != d1) && (bound >= Lmin - 36.0f);
          mask = __ballot(need); }
        if (mask) {
#define DA_POP(v) do { v = -1; if (mask) { v = (int)__builtin_ctzll(mask); mask &= mask - 1; } } while (0)
            int cur, n1, n2; DA_POP(cur); DA_POP(n1);
            unsigned bo = 0;
            DA_LOADT(sa, cur); DA_LOADT(sb, (n1 >= 0 ? n1 : cur));
            DA_STORET(sa, 0);
            __syncthreads();
#define DA_STEP(X, Y) { DA_POP(n2); DA_LOADT(Y, (n2 >= 0 ? n2 : cur)); DA_COMPUTE(cur, bo, false, true); if (n1 < 0) break; DA_STORET(X, bo ^ 32768); __syncthreads(); bo ^= 32768; cur = n1; n1 = n2; }
            for (;;) { DA_STEP(sb, sa) DA_STEP(sa, sb) }
#undef DA_STEP
#undef DA_POP
        }
        __syncthreads();
#undef DA_LOADT
#undef DA_STORET
#undef DA_COMPUTE
        l += __shfl_xor(l, 32);
        const float inv = 1.0f / l;
        if (mp == 1) {
#pragma unroll
            for (int d = 0; d < 4; ++d)
#pragma unroll
                for (int r = 0; r < 16; ++r) xch[(d * 16 + r) * 64] = o[d][r] * inv;
        }
        __syncthreads();
        if (mp == 0) {
            float ss = 0.f;
#pragma unroll
            for (int d = 0; d < 4; ++d)
#pragma unroll
                for (int r = 0; r < 16; ++r) { const float v = o[d][r] * inv - lam * xch[(d * 16 + r) * 64]; o[d][r] = v; ss += v * v; }
            ss += __shfl_xor(ss, 32);
            const float rs = rsqrtf(ss * (1.0f / 128.0f) + 1e-5f) * outscale;
            GAS bf16_t* op = AO + (tokb + qpos) * 1024 + h * 128 + 4 * hi;
#pragma unroll
            for (int d = 0; d < 4; ++d)
#pragma unroll
                for (int r4 = 0; r4 < 4; ++r4) { const f32x4 g = *(const GAS f32x4*)(subln + 32 * d + 8 * r4 + 4 * hi);
                    u32x2 w; w.x = cvtpk(o[d][4 * r4] * rs * g[0], o[d][4 * r4 + 1] * rs * g[1]); w.y = cvtpk(o[d][4 * r4 + 2] * rs * g[2], o[d][4 * r4 + 3] * rs * g[3]);
                    *(GAS u32x2*)(op + 32 * d + 8 * r4) = w; }
        }
    }
}
#undef GAS

#define GAS __attribute__((address_space(1)))
constexpr int NA_RING = 147456, NA_TB = NA_RING;
__device__ __forceinline__ void na_phase(LAS unsigned char* lds, const bf16_t* QK_, const bf16_t* VT_, bf16_t* AO_, const float* rpb_, int G, int bx) {
    int tid_ = threadIdx.x; asm volatile("" : "+v"(tid_));
    const int tid = tid_, lane = tid & 63, wid = __builtin_amdgcn_readfirstlane(tid >> 6), n = lane & 15, g = lane >> 4;
    const GAS bf16_t* QK = (const GAS bf16_t*)QK_; const GAS bf16_t* VT = (const GAS bf16_t*)VT_; GAS bf16_t* AO = (GAS bf16_t*)AO_; const GAS float* rpb = (const GAS float*)rpb_;
    LAS float* tb = (LAS float*)(lds + NA_TB);
    const int rq = wid >> 2, qg = wid & 3, c0 = 16 * qg, cw0 = (qg == 0) ? 0 : (qg == 1) ? 8 : (qg == 2) ? 24 : 32;
    const int c = c0 + n, cs = min(max(c - 8, 0), 48);
    unsigned ka[2], va[2];
#pragma unroll
    for (int ks = 0; ks < 2; ++ks) ka[ks] = (cw0 + n) * 128 + (((4 * ks + g) ^ (n & 7)) * 16);
    { const int c8 = (cw0 >> 2) + g; va[0] = 8192 + n * 128 + (((c8 >> 1) ^ (n & 7)) * 16) + (c8 & 1) * 8; va[1] = 8192 + n * 128 + ((((c8 >> 1) + 2) ^ (n & 7)) * 16) + (c8 & 1) * 8; }
    const int tr = tid >> 3, tc = tid & 7;
    const unsigned sdst = tr * 128 + ((tc ^ (tr & 7)) * 16);
    int bidx[8]; unsigned vmask = 0;
#pragma unroll
    for (int j8 = 0; j8 < 8; ++j8) { const int kc = cw0 + 16 * (j8 >> 2) + 4 * g + (j8 & 3); bidx[j8] = min(max(kc - c + 15, 0), 30); vmask |= ((unsigned)(kc - cs) < 16u) ? (1u << j8) : 0u; }
    for (int un = bx; un < 256; un += G) {
        const int b = un >> 4, h = un & 15;
        __syncthreads();
        for (int i = tid; i < 15 * 31; i += 512) tb[i] = rpb[h * 465 + i] * LOG2E;
        const GAS bf16_t* ksrc = QK + ((size_t)b * SEQ + tr) * 2048 + 1024 + h * 64 + tc * 8;
        const GAS bf16_t* vsrc = VT + (size_t)(h * 64 + tr) * MTOK + (size_t)b * SEQ + tc * 8;
#define NA_LDK(row) (*(const GAS u32x4*)(ksrc + (size_t)(row) * 64 * 2048))
#define NA_LDV(row) (*(const GAS u32x4*)(vsrc + (row) * 64))
#define NA_ST(row, kv, vv_) do { const unsigned so_ = (unsigned)((row) % 9) * 16384u + sdst; *(LAS u32x4*)(lds + so_) = (kv); *(LAS u32x4*)(lds + so_ + 8192) = (vv_); } while (0)
#pragma unroll
        for (int row = 0; row < 8; row += 4) { const u32x4 a0 = NA_LDK(row), b0 = NA_LDV(row), a1 = NA_LDK(row + 1), b1 = NA_LDV(row + 1), a2 = NA_LDK(row + 2), b2 = NA_LDV(row + 2), a3 = NA_LDK(row + 3), b3 = NA_LDV(row + 3);
            NA_ST(row, a0, b0); NA_ST(row + 1, a1, b1); NA_ST(row + 2, a2, b2); NA_ST(row + 3, a3, b3); }
        int loaded_hi = 7;
        const GAS bf16_t* qbase = QK + ((size_t)b * SEQ + rq * 64 + c0 + n) * 2048 + h * 64 + 8 * g;
        bf16x8 q0 = *(const GAS bf16x8*)qbase, q1 = *(const GAS bf16x8*)(qbase + 32);
        __syncthreads();
        for (int s = 0; s < 32; ++s) {
            const int tgt = (s < 31) ? (min(max(2 * s - 1, 0), 56) + 7) : loaded_hi;
            const int nnew = tgt - loaded_hi;
            const int ra_ = min(loaded_hi + 1, 63), rb_ = min(loaded_hi + 2, 63);
            const u32x4 p0 = NA_LDK(ra_), p1 = NA_LDV(ra_), p2 = NA_LDK(rb_), p3 = NA_LDV(rb_);
            const int sn = (s < 31) ? s + 1 : s;
            const bf16x8 q0n = *(const GAS bf16x8*)(qbase + (size_t)sn * 128 * 2048), q1n = *(const GAS bf16x8*)(qbase + (size_t)sn * 128 * 2048 + 32);
            const int r = 2 * s + rq, rs = min(max(r - 4, 0), 56);
            const int slot0 = rs % 9;
            float bvl[8][8];
#pragma unroll
            for (int kr = 0; kr < 8; ++kr) { const LAS float* rowp = tb + (rs + kr - r + 7) * 31;
#pragma unroll
                for (int j8 = 0; j8 < 8; ++j8) bvl[kr][j8] = rowp[bidx[j8]]; }
            __builtin_amdgcn_sched_group_barrier(0x100, 64, 0);
            f32x4 st[16];
#pragma unroll
            for (int kp = 0; kp < 4; ++kp) {
                bf16x8 kf[2][2][2];
#pragma unroll
                for (int k2 = 0; k2 < 2; ++k2) { int sl = slot0 + 2 * kp + k2; sl = (sl >= 9) ? sl - 9 : sl; const unsigned base = (unsigned)sl * 16384u;
#pragma unroll
                    for (int hf = 0; hf < 2; ++hf) { kf[k2][hf][0] = *(const LAS bf16x8*)(lds + base + hf * 2048 + ka[0]); kf[k2][hf][1] = *(const LAS bf16x8*)(lds + base + hf * 2048 + ka[1]); } }
#pragma unroll
                for (int k2 = 0; k2 < 2; ++k2)
#pragma unroll
                    for (int hf = 0; hf < 2; ++hf) { f32x4 a = __builtin_amdgcn_mfma_f32_16x16x32_bf16(kf[k2][hf][0], q0, (f32x4){0.f, 0.f, 0.f, 0.f}, 0, 0, 0);
                        st[(2 * kp + k2) * 2 + hf] = __builtin_amdgcn_mfma_f32_16x16x32_bf16(kf[k2][hf][1], q1, a, 0, 0, 0); }
                __builtin_amdgcn_sched_group_barrier(0x100, 8, 0); __builtin_amdgcn_sched_group_barrier(0x008, 8, 0);
            }
            float mx = -INFINITY;
#pragma unroll
            for (int kr = 0; kr < 8; ++kr)
#pragma unroll
                for (int j8 = 0; j8 < 8; ++j8) { const float v = ((vmask >> j8) & 1u) ? st[kr * 2 + (j8 >> 2)][j8 & 3] + bvl[kr][j8] : -INFINITY; st[kr * 2 + (j8 >> 2)][j8 & 3] = v; mx = __builtin_fmaxf(mx, v); }
            mx = __builtin_fmaxf(mx, __shfl_xor(mx, 16)); mx = __builtin_fmaxf(mx, __shfl_xor(mx, 32));
            float l = 0.f;
#pragma unroll
            for (int ti = 0; ti < 16; ++ti)
#pragma unroll
                for (int i = 0; i < 4; ++i) { const float e = __builtin_amdgcn_exp2f(st[ti][i] - mx); st[ti][i] = e; l += e; }
            l += __shfl_xor(l, 16); l += __shfl_xor(l, 32);
            const float inv = 1.0f / l;
            f32x4 o[4];
#pragma unroll
            for (int dt = 0; dt < 4; ++dt) o[dt] = (f32x4){0.f, 0.f, 0.f, 0.f};
#pragma unroll
            for (int kp = 0; kp < 4; ++kp) {
                u32x2 vv[2][4][2];
#pragma unroll
                for (int k2 = 0; k2 < 2; ++k2) { int sl = slot0 + 2 * kp + k2; sl = (sl >= 9) ? sl - 9 : sl; const unsigned base = (unsigned)sl * 16384u;
#pragma unroll
                    for (int dt = 0; dt < 4; ++dt) { vv[k2][dt][0] = *(const LAS u32x2*)(lds + base + dt * 2048 + va[0]); vv[k2][dt][1] = *(const LAS u32x2*)(lds + base + dt * 2048 + va[1]); } }
#pragma unroll
                for (int k2 = 0; k2 < 2; ++k2) { const int kr = 2 * kp + k2;
                    u32x4 w; w.x = cvtpk(st[2 * kr][0], st[2 * kr][1]); w.y = cvtpk(st[2 * kr][2], st[2 * kr][3]); w.z = cvtpk(st[2 * kr + 1][0], st[2 * kr + 1][1]); w.w = cvtpk(st[2 * kr + 1][2], st[2 * kr + 1][3]);
                    const bf16x8 pf = __builtin_bit_cast(bf16x8, w);
#pragma unroll
                    for (int dt = 0; dt < 4; ++dt) { const u32x4 v4 = {vv[k2][dt][0].x, vv[k2][dt][0].y, vv[k2][dt][1].x, vv[k2][dt][1].y};
                        o[dt] = __builtin_amdgcn_mfma_f32_16x16x32_bf16(__builtin_bit_cast(bf16x8, v4), pf, o[dt], 0, 0, 0); } }
                __builtin_amdgcn_sched_group_barrier(0x100, 16, 0); __builtin_amdgcn_sched_group_barrier(0x008, 8, 0);
            }
            GAS bf16_t* op = AO + ((size_t)b * SEQ + r * 64 + c0 + n) * 1024 + h * 64 + 4 * g;
#pragma unroll
            for (int dt = 0; dt < 4; ++dt) { u32x2 w; w.x = cvtpk(o[dt][0] * inv, o[dt][1] * inv); w.y = cvtpk(o[dt][2] * inv, o[dt][3] * inv); *(GAS u32x2*)(op + 16 * dt) = w; }
            __syncthreads();
            if (nnew >= 1) NA_ST(loaded_hi + 1, p0, p1);
            if (nnew >= 2) NA_ST(loaded_hi + 2, p2, p3);
            loaded_hi = tgt; q0 = q0n; q1 = q1n;
            __syncthreads();
        }
#undef NA_LDK
#undef NA_LDV
#undef NA_ST
    }
}
#undef GAS
#undef LAS
}
#define LAS __attribute__((address_space(3)))
typedef unsigned short bf16;
typedef unsigned v4u __attribute__((ext_vector_type(4)));
typedef unsigned v2u __attribute__((ext_vector_type(2)));
typedef float f32x4 __attribute__((ext_vector_type(4)));
constexpr int NWAVES = 8, NTHR = 512;
constexpr int M = 65536, D = 1024, FF = 2816, PLE = 256, DEPTH = 4, SEQ = 4096;
constexpr size_t MiB = 1u << 20;
constexpr size_t WS_SSQ = 913 * MiB;
constexpr size_t WS_W = 4 * MiB, W_LAYER = 27 * MiB;
constexpr size_t WO_QKV = 0, WO_O = 6 * MiB, WO_GU = 8 * MiB, WO_DN = 19 * MiB, WO_PG = 19 * MiB + 5632 * 1024, WO_PP = WO_PG + 2 * MiB;
constexpr size_t WS_PB = 112 * MiB;
constexpr size_t WS_HB0 = 144 * MiB, WS_HB1 = 272 * MiB;
constexpr size_t WS_QK = 400 * MiB, WS_VT = 656 * MiB;
constexpr size_t WS_HID = 400 * MiB;
constexpr size_t WS_AO = 784 * MiB;
constexpr size_t WS_BAR = 912 * MiB;
constexpr size_t WS_KN = 920 * MiB;
constexpr size_t WS_END = 921 * MiB;
static_assert(WO_PP + (size_t)1024 * 256 * 2 <= W_LAYER && WS_W + 4 * W_LAYER <= WS_PB && WS_HID + (size_t)M * FF * 2 <= WS_AO, "ws map");
constexpr int LDS_BYTES = 155648;

struct Params {
    const float* in[22];
    float* out; unsigned char* ws;
};

__device__ __forceinline__ unsigned f2bf(float f) { unsigned u = __builtin_bit_cast(unsigned, f); return (u + 0x7fffu + ((u >> 16) & 1u)) >> 16; }
__device__ __forceinline__ unsigned pk2(float lo, float hi) { return f2bf(lo) | (f2bf(hi) << 16); }
__device__ __forceinline__ float wave_sum(float v) {
#pragma unroll
    for (int o = 1; o < 64; o <<= 1) v += __shfl_xor(v, o);
    return v;
}
__device__ __forceinline__ void transpose_item(const float* __restrict__ W, int K, int N, const float* __restrict__ gk, bf16* __restrict__ WT, int grp, int gstride, int goff, LAS float* scr, int item, int lane) {
    const int nblk = N / 32, kb = item / nblk, nb = item % nblk, k0 = 64 * kb, n0 = 32 * nb;
    float wv_[32], gs_[32];
#pragma unroll
    for (int i = 0; i < 32; ++i) { const int kk = 2 * i + (lane >> 5); gs_[i] = gk ? ((const __attribute__((address_space(1))) float*)gk)[k0 + kk] : 1.f; wv_[i] = ((const __attribute__((address_space(1))) float*)W)[(size_t)(k0 + kk) * N + n0 + (lane & 31)]; }
#pragma unroll
    for (int i = 0; i < 32; ++i) { const int kk = 2 * i + (lane >> 5); scr[kk * 33 + (lane & 31)] = wv_[i] * gs_[i]; }
    asm volatile("s_waitcnt lgkmcnt(0)" ::: "memory");
    const int c = lane & 7;
#pragma unroll
    for (int j = 0; j < 4; ++j) { const int n = (lane >> 3) + 8 * j; const LAS float* s = scr + (8 * c) * 33 + n;
        v4u o; o.x = pk2(s[0 * 33], s[1 * 33]); o.y = pk2(s[2 * 33], s[3 * 33]); o.z = pk2(s[4 * 33], s[5 * 33]); o.w = pk2(s[6 * 33], s[7 * 33]);
        const int nn = n0 + n, orow = (nn / grp) * gstride + goff + (nn % grp);
        *(__attribute__((address_space(1))) v4u*)(WT + (size_t)orow * K + k0 + 8 * c) = o; }
    asm volatile("s_waitcnt lgkmcnt(0)" ::: "memory");
}

__global__ void __launch_bounds__(NTHR) fwd_megakernel(Params P) {
    extern __shared__ __attribute__((aligned(16))) unsigned char lds_raw[];
    cg::grid_group grid = cg::this_grid();
    unsigned bar_gen = 0;
#define GRID_SYNC() do { asm volatile("s_waitcnt vmcnt(0) lgkmcnt(0)" ::: "memory"); __syncthreads(); \
        if (threadIdx.x == 0) { __builtin_amdgcn_fence(__ATOMIC_RELEASE, "agent"); asm volatile("s_waitcnt vmcnt(0)" ::: "memory"); bar_gen += 1u; \
              \
            const unsigned ngrp_ = (gridDim.x & 7u) ? 1u : 8u, gsz_ = gridDim.x / ngrp_; \
            unsigned* top_ = (unsigned*)(P.ws + WS_BAR); unsigned* grp_ = top_ + 64u * (1u + (ngrp_ == 8u ? (blockIdx.x & 7u) : 0u)); \
            const unsigned old_ = __hip_atomic_fetch_add(grp_, 1u, __ATOMIC_RELAXED, __HIP_MEMORY_SCOPE_AGENT); \
            if (old_ + 1u == gsz_ * bar_gen) __hip_atomic_fetch_add(top_, 1u, __ATOMIC_RELAXED, __HIP_MEMORY_SCOPE_AGENT); \
            while (__hip_atomic_load(top_, __ATOMIC_RELAXED, __HIP_MEMORY_SCOPE_AGENT) < ngrp_ * bar_gen) __builtin_amdgcn_s_sleep(1); \
            __builtin_amdgcn_fence(__ATOMIC_ACQUIRE, "agent"); asm volatile("s_waitcnt vmcnt(0)" ::: "memory"); } \
        __syncthreads(); } while (0)
    LAS unsigned char* lds = (LAS unsigned char*)lds_raw;
#define OPQ_TID() int tid = threadIdx.x; asm volatile("" : "+v"(tid)); const int lane = tid & 63, wave = __builtin_amdgcn_readfirstlane(tid >> 6); \
        const int G = gridDim.x, bx = blockIdx.x, gw = bx * NWAVES + wave, NGW = G * NWAVES; (void)lane; (void)gw; (void)NGW; (void)G; (void)bx
#define OPQ_WS() unsigned char* ws = P.ws; asm volatile("" : "+s"(ws)); pg8::u64* ssq = (pg8::u64*)(ws + WS_SSQ); float* out = P.out; asm volatile("" : "+s"(out))
#define OPQ_LAYER() OPQ_WS(); int lo = li; asm volatile("" : "+s"(lo)); const int j = lo >> 1; unsigned char* wl = ws + WS_W + (size_t)lo * W_LAYER; \
        bf16* HBc = (bf16*)(ws + ((lo & 1) ? WS_HB1 : WS_HB0)); bf16* HBn = (bf16*)(ws + ((lo & 1) ? WS_HB0 : WS_HB1)); \
        pg8::u64* ssq_mix = ssq + (size_t)(3 * lo) * M; pg8::u64* ssq_ffn = ssq_mix + M; pg8::u64* ssq_ple = ssq_ffn + M; pg8::u64* ssq_nxt = ssq_ple + M; \
        bf16* QK = (bf16*)(ws + WS_QK); bf16* VT = (bf16*)(ws + WS_VT); bf16* HID = (bf16*)(ws + WS_HID); bf16* AO = (bf16*)(ws + WS_AO); bf16* PB = (bf16*)(ws + WS_PB); \
        (void)j; (void)wl; (void)HBc; (void)HBn; (void)ssq_mix; (void)ssq_ffn; (void)ssq_ple; (void)ssq_nxt; (void)QK; (void)VT; (void)HID; (void)AO; (void)PB
    {
        OPQ_TID(); OPQ_WS(); (void)out; bf16* HB0 = (bf16*)(ws + WS_HB0);
        const float* x = P.in[0]; const float* norm_mix = P.in[2]; const float* norm_ffn = P.in[3]; const float* norm_ple = P.in[4];
        LAS float* scr = (LAS float*)(lds + wave * 16384);
        constexpr int I_QKV = 16 * 96, I_O = 16 * 32, I_G = 16 * 88, I_DN = 44 * 32, I_PG = 16 * 32, I_PP = 4 * 32, I_LAYER = I_QKV + I_O + 2 * I_G + I_DN + I_PG + I_PP;
        for (int it = gw; it < DEPTH * I_LAYER; it += NGW) {
            const int li = it / I_LAYER, j = li >> 1; int r = it % I_LAYER;
            unsigned char* wl = ws + WS_W + (size_t)li * W_LAYER;
            if (r < I_QKV) { const float* W = (li & 1) ? P.in[13] + (size_t)j * D * 3 * D : P.in[6] + (size_t)j * D * 3 * D;
                transpose_item(W, D, 3 * D, norm_mix + li * D, (bf16*)(wl + WO_QKV), 3 * D, 0, 0, scr, r, lane); continue; } r -= I_QKV;
            if (r < I_O) { const float* W = (li & 1) ? P.in[16] + (size_t)j * D * D : P.in[7] + (size_t)j * D * D;
                transpose_item(W, D, D, nullptr, (bf16*)(wl + WO_O), D, 0, 0, scr, r, lane); continue; } r -= I_O;
            if (r < I_G) { transpose_item(P.in[17] + (size_t)li * D * FF, D, FF, norm_ffn + li * D, (bf16*)(wl + WO_GU), 128, 256, 0, scr, r, lane); continue; } r -= I_G;
            if (r < I_G) { transpose_item(P.in[18] + (size_t)li * D * FF, D, FF, norm_ffn + li * D, (bf16*)(wl + WO_GU), 128, 256, 128, scr, r, lane); continue; } r -= I_G;
            if (r < I_DN) { transpose_item(P.in[19] + (size_t)li * FF * D, FF, D, nullptr, (bf16*)(wl + WO_DN), D, 0, 0, scr, r, lane); continue; } r -= I_DN;
            if (r < I_PG) { transpose_item(P.in[21] + (size_t)li * D * D, D, D, norm_ple + li * D, (bf16*)(wl + WO_PG), D, 0, 0, scr, r, lane); continue; } r -= I_PG;
            transpose_item(P.in[20] + (size_t)li * PLE * D, PLE, D, nullptr, (bf16*)(wl + WO_PP), D, 0, 0, scr, r, lane);
        }
        for (int g32 = gw; g32 < M / 32; g32 += NGW) {
            float keep = 0.f;
#pragma unroll 4
            for (int rr = 0; rr < 32; ++rr) {
                const int m = g32 * 32 + rr;
                const f32x4* xr = (const f32x4*)(x + (size_t)m * D) + lane; f32x4 v[4]; float sq = 0.f;
#pragma unroll
                for (int jj = 0; jj < 4; ++jj) { v[jj] = xr[64 * jj]; sq += (v[jj].x * v[jj].x + v[jj].y * v[jj].y) + (v[jj].z * v[jj].z + v[jj].w * v[jj].w); }
                sq = wave_sum(sq); if (lane == rr) keep = sq;
                v2u* o8 = (v2u*)(HB0 + (size_t)m * D) + lane;
#pragma unroll
                for (int jj = 0; jj < 4; ++jj) { v2u w; w.x = pk2(v[jj].x, v[jj].y); w.y = pk2(v[jj].z, v[jj].w); o8[64 * jj] = w; }
            }
            if (lane < 32) ssq[g32 * 32 + lane] = (pg8::u64)(keep * pg8::SSQ_FIX + 0.5f);
        }
        for (int i = bx * NTHR + tid; i < 12 * M / 2; i += G * NTHR) ((v4u*)(ssq + M))[i] = (v4u){0u, 0u, 0u, 0u};
    }
    GRID_SYNC();
    grid.sync();

#pragma unroll 1
    for (int li = 0; li < DEPTH; ++li) {
        const bool is_da = (li & 1) == 0;
        {
            OPQ_TID(); OPQ_LAYER();
            const float* bqkv = is_da ? nullptr : P.in[14] + (size_t)j * 3 * D;
            { pg8::Gemm g{HBc, (const bf16*)(wl + WO_QKV), M, 2 * D, D}; pg8::StaticOrder S; S.init(M, 2 * D, G, bx);
              pg8::EpiQK E{QK, 2 * D, ssq_mix, bqkv, D, 0.125f * 1.4426950408889634f};
              GEMM_CALL_EpiQK(pg8::gemm_phase<pg8::EpiQK, pg8::StaticOrder, true, true>(lds, g, S, E)); }
            { pg8::Gemm g{(const bf16*)(wl + WO_QKV) + (size_t)2 * D * D, HBc, D, M, D}; pg8::StaticOrder S; S.init(D, M, G, bx);
              pg8::EpiVT E{VT, M, ssq_mix, bqkv ? bqkv + 2 * D : nullptr};
              GEMM_CALL_EpiVT(pg8::gemm_phase<pg8::EpiVT, pg8::StaticOrder, true, true>(lds, g, S, E)); }
        }
        GRID_SYNC();
        { OPQ_TID(); OPQ_LAYER(); const float* pin = P.in[1];
        if (is_da) {
            float d1 = 0.f, d2 = 0.f;
            { const float* q1 = P.in[8] + j * 64; const float* k1 = P.in[9] + j * 64; const float* q2 = P.in[10] + j * 64; const float* k2 = P.in[11] + j * 64;
              d1 = wave_sum(q1[lane] * k1[lane]); d2 = wave_sum(q2[lane] * k2[lane]); }
            const float lam_init = 0.8f - 0.6f * __expf(-0.3f * (float)li);
            const float lam = __expf(d1) - __expf(d2) + lam_init;
#ifndef NO_DA
            float* KN = (float*)(ws + WS_KN);
            att::da_knorm(QK, KN, gw, NGW, lane);
            GRID_SYNC();
            att::da_phase(lds, QK, VT, AO, KN, lam, 1.0f - lam_init, P.in[12] + j * 128, G, bx);
#else
            for (int i = bx * NTHR + tid; i < M * D / 8; i += G * NTHR) ((v4u*)AO)[i] = (v4u){0u, 0u, 0u, 0u};
#endif
        } else {
#ifndef NO_NA
            att::na_phase(lds, QK, VT, AO, P.in[15] + (size_t)j * 16 * 15 * 31, G, bx);
#else
            for (int i = bx * NTHR + tid; i < M * D / 8; i += G * NTHR) ((v4u*)AO)[i] = (v4u){0u, 0u, 0u, 0u};
#endif
        }
#ifdef EXP_TWICE
        if (is_da && li == 0) {
            GRID_SYNC();
            { float d1 = wave_sum(P.in[8][lane] * P.in[9][lane]), d2 = wave_sum(P.in[10][lane] * P.in[11][lane]); const float lam_init = 0.8f - 0.6f * __expf(-0.3f * (float)li);
              att::da_phase(lds, QK, VT, (bf16*)(ws + WS_HB1), (float*)(ws + WS_KN), __expf(d1) - __expf(d2) + lam_init, 1.0f - lam_init, P.in[12], G, bx); }
            GRID_SYNC();
            { const v4u* a = (const v4u*)AO; const v4u* c = (const v4u*)(ws + WS_HB1); unsigned bad = 0;
              for (int i = bx * NTHR + tid; i < M * D / 8; i += G * NTHR) { const v4u u = a[i], w = c[i]; bad |= (u.x ^ w.x) | (u.y ^ w.y) | (u.z ^ w.z) | (u.w ^ w.w); }
              if (bad) __hip_atomic_store((unsigned*)(ws + WS_BAR + 128), 1u, __ATOMIC_RELAXED, __HIP_MEMORY_SCOPE_AGENT); }
        }
#endif
        { const f32x4* src = (const f32x4*)(pin + (size_t)li * M * PLE); v4u* dst = (v4u*)PB;
          const int str_ = G * NTHR;
          for (int i = bx * NTHR + tid; i < M * PLE / 8; i += 4 * str_) { f32x4 a[4], c[4];
#pragma unroll
              for (int k = 0; k < 4; ++k) { const int ii = min(i + k * str_, M * PLE / 8 - 1); a[k] = ((const __attribute__((address_space(1))) f32x4*)src)[2 * ii]; c[k] = ((const __attribute__((address_space(1))) f32x4*)src)[2 * ii + 1]; }
#pragma unroll
              for (int k = 0; k < 4; ++k) { const int ii = i + k * str_; if (ii < M * PLE / 8) { v4u w; w.x = pk2(a[k].x, a[k].y); w.y = pk2(a[k].z, a[k].w); w.z = pk2(c[k].x, c[k].y); w.w = pk2(c[k].z, c[k].w); ((__attribute__((address_space(1))) v4u*)dst)[ii] = w; } } } }
        }
        GRID_SYNC();
        { OPQ_TID(); OPQ_LAYER(); const float* x = P.in[0];
          pg8::Gemm g{AO, (const bf16*)(wl + WO_O), M, D, D}; pg8::StaticOrder S; S.init(M, D, G, bx);
          pg8::EpiResid E{HBc, HBc, ssq_ffn}; (void)x;
          GEMM_CALL_EpiResid(pg8::gemm_phase<pg8::EpiResid, pg8::StaticOrder, true, true>(lds, g, S, E)); }
        GRID_SYNC();
        { OPQ_TID(); OPQ_LAYER();
          pg8::Gemm g{HBc, (const bf16*)(wl + WO_GU), M, 2 * FF, D}; pg8::StaticOrder S; S.init(M, 2 * FF, G, bx);
          pg8::EpiSwiGLU E{HID, ssq_ffn};
          GEMM_CALL_EpiSwiGLU(pg8::gemm_phase<pg8::EpiSwiGLU, pg8::StaticOrder, true, true>(lds, g, S, E)); }
        { OPQ_TID(); OPQ_LAYER();
          pg8::Gemm g{PB, (const bf16*)(wl + WO_PP), M, D, PLE}; pg8::StaticOrder S; S.init(M, D, G, bx);
          pg8::EpiQK E{AO, D, nullptr, nullptr, 0, 1.f};
          GEMM_CALL_EpiQK(pg8::gemm_phase<pg8::EpiQK, pg8::StaticOrder, true, true>(lds, g, S, E)); }
        GRID_SYNC();
        { OPQ_TID(); OPQ_LAYER();
          pg8::Gemm g{HID, (const bf16*)(wl + WO_DN), M, D, FF}; pg8::StaticOrder S; S.init(M, D, G, bx);
          pg8::EpiResid E{HBc, HBc, ssq_ple};
          GEMM_CALL_EpiResid(pg8::gemm_phase<pg8::EpiResid, pg8::StaticOrder, true, true>(lds, g, S, E)); }
        GRID_SYNC();
        { OPQ_TID(); OPQ_LAYER();
          pg8::Gemm g{HBc, (const bf16*)(wl + WO_PG), M, D, D}; pg8::StaticOrder S; S.init(M, D, G, bx);
          pg8::EpiPle E{HBc, AO, HBn, ssq_ple, ssq_nxt};
          GEMM_CALL_EpiPle(pg8::gemm_phase<pg8::EpiPle, pg8::StaticOrder, true, true>(lds, g, S, E)); }
        GRID_SYNC();
    }
    {
        OPQ_TID(); OPQ_WS(); const float* norm_final = P.in[5];
        const pg8::u64* sq = ssq + (size_t)12 * M;
        typedef __attribute__((address_space(1))) f32x4 gf4; typedef __attribute__((address_space(1))) v2u gu2;
        const bf16* HBf = (const bf16*)(ws + ((DEPTH & 1) ? WS_HB1 : WS_HB0));
        f32x4 gg[4];
#pragma unroll
        for (int jj = 0; jj < 4; ++jj) gg[jj] = ((const gf4*)norm_final)[lane + 64 * jj];
        for (int m0 = gw; m0 < M; m0 += 4 * NGW) {
            v2u v[4][4]; pg8::u64 q4[4];
#pragma unroll
            for (int k = 0; k < 4; ++k) { const int m = m0 + k * NGW; q4[k] = ((const __attribute__((address_space(1))) pg8::u64*)sq)[m];
#pragma unroll
                for (int jj = 0; jj < 4; ++jj) v[k][jj] = ((const gu2*)(HBf + (size_t)m * D))[lane + 64 * jj]; }
#pragma unroll
            for (int k = 0; k < 4; ++k) { const int m = m0 + k * NGW; const float rs = pg8::rstd_of(q4[k]);
#pragma unroll
                for (int jj = 0; jj < 4; ++jj) { const v2u w = v[k][jj]; f32x4 f; f[0] = __uint_as_float(w.x << 16); f[1] = __uint_as_float(w.x & 0xffff0000u); f[2] = __uint_as_float(w.y << 16); f[3] = __uint_as_float(w.y & 0xffff0000u);
                    ((gf4*)(out + (size_t)m * D))[lane + 64 * jj] = f * rs * gg[jj]; } }
        }
        for (int m = M; m < M; ++m) { f32x4* hr = nullptr; (void)hr;
#ifdef EXP_TWICE
            if (__hip_atomic_load((unsigned*)(ws + WS_BAR + 128), __ATOMIC_RELAXED, __HIP_MEMORY_SCOPE_AGENT)) { const float qn = __builtin_nanf("");
                for (int jj = 0; jj < 4; ++jj) hr[64 * jj] = (f32x4){qn, qn, qn, qn}; }
#endif
        }
    }
}

extern "C" void kernel_launch(void* const* d_in, const int* in_sizes, int n_in, void* d_out, int out_size, void* d_ws, size_t ws_size, hipStream_t stream) {
    static int grid_blocks = 0;
    if (grid_blocks == 0) {
        if (n_in != 22 || out_size != M * D || ws_size < WS_END) { fprintf(stderr, "kernel_launch: unexpected shapes (n_in %d, out %d, ws %zu)\n", n_in, out_size, ws_size); grid_blocks = -1; return; }
        int dev = 0, cus = 0, per_cu = 0;
        hipGetDevice(&dev);
        hipDeviceGetAttribute(&cus, hipDeviceAttributeMultiprocessorCount, dev);
        if (hipFuncSetAttribute((const void*)fwd_megakernel, hipFuncAttributeMaxDynamicSharedMemorySize, LDS_BYTES) != hipSuccess) fprintf(stderr, "kernel_launch: hipFuncSetAttribute failed\n");
        if (hipOccupancyMaxActiveBlocksPerMultiprocessor(&per_cu, (const void*)fwd_megakernel, NTHR, LDS_BYTES) != hipSuccess || per_cu < 1) { fprintf(stderr, "kernel_launch: occupancy query gave %d\n", per_cu); per_cu = 1; }
        (void)hipGetLastError();
        grid_blocks = cus * per_cu;
    }
    if (grid_blocks < 0) return;
    if (hipMemsetAsync((char*)d_ws + WS_BAR, 0, 4096, stream) != hipSuccess) { fprintf(stderr, "kernel_launch: memset failed\n"); return; }
    Params p{};
    for (int i = 0; i < 22; ++i) p.in[i] = (const float*)d_in[i];
    p.out = (float*)d_out; p.ws = (unsigned char*)d_ws;
    void* args[] = {&p};
    hipError_t e = hipLaunchCooperativeKernel((const void*)fwd_megakernel, dim3(grid_blocks), dim3(NTHR), args, LDS_BYTES, stream);
    if (e != hipSuccess) fprintf(stderr, "cooperative launch failed: %s (grid %d)\n", hipGetErrorString(e), grid_blocks);
}
```

```cpp
#ifndef GQ
#define GQ(...) __VA_ARGS__
#endif
#ifndef GV
#define GV(...) __VA_ARGS__
#endif
#ifndef GR
#define GR(...) __VA_ARGS__
#endif
#ifndef GS
#define GS(...) __VA_ARGS__
#endif
#ifndef GP
#define GP(...) __VA_ARGS__
#endif
#define GEMM_CALL_EpiQK(...) GQ(__VA_ARGS__)
#define GEMM_CALL_EpiVT(...) GV(__VA_ARGS__)
#define GEMM_CALL_EpiResid(...) GR(__VA_ARGS__)
#define GEMM_CALL_EpiSwiGLU(...) GS(__VA_ARGS__)
#define GEMM_CALL_EpiPle(...) GP(__VA_ARGS__)
#include <hip/hip_runtime.h>
#include <hip/hip_cooperative_groups.h>
#include <cstdio>
#include <cstdint>
namespace cg = cooperative_groups;
namespace pg8 {
#define PG8_LAS __attribute__((address_space(3)))
typedef unsigned short bf16_t;
typedef short bf16x8 __attribute__((ext_vector_type(8)));
typedef float f32x4 __attribute__((ext_vector_type(4)));
typedef unsigned u32x4 __attribute__((ext_vector_type(4)));
constexpr int BM = 256, BK = 64, HALF = 128, HTB = HALF * BK * 2  , STAGE_BYTES = 8 * HTB, NXCD = 8, WGM = 8;

__host__ __device__ __forceinline__ int lds_byte(int r, int c) { const int st = (r >> 4) * 2 + (c >> 5), rr = r & 15, cc = c & 31, ob = rr * 64 + cc * 2; return st * 1024 + (ob ^ (((ob >> 9) & 1) << 5)); }
__host__ __device__ __forceinline__ void stage_rc(int b, int& R, int& C) { const int st = b / 1024, sb = b % 1024, swz = sb ^ (((sb >> 9) & 1) << 5); R = (st >> 1) * 16 + swz / 64; C = (st & 1) * 32 + (swz % 64) / 2; }
__host__ __device__ __forceinline__ int perm32(int rho) { const int n = rho >> 4, i = rho & 15; return 8 * (i >> 2) + 4 * n + (i & 3); }

struct Unit { int pm, pn; };
struct Gemm { const bf16_t* A; const bf16_t* Bt; int M, N, K; };

struct StaticOrder {
    int nM, nN, nwg, G, c;
    __host__ __device__ void init(int M, int N, int G_, int c_) { nM = M / BM; nN = N / BM; nwg = nM * nN; G = G_; c = c_; }
    __host__ __device__ bool next(int i, Unit& u) const {
        const long L = (long)i * G + c; if (L >= nwg) return false;
        int wgid = (int)L; { const int q = nwg / NXCD, r = nwg % NXCD, xcd = wgid % NXCD, off = wgid / NXCD; wgid = (xcd < r ? xcd * (q + 1) : r * (q + 1) + (xcd - r) * q) + off; }
        const int nig = WGM * nN, gid = wgid / nig, fm = gid * WGM, gsz = (nM - fm) < WGM ? (nM - fm) : WGM;
        u.pm = fm + ((wgid % nig) % gsz); u.pn = (wgid % nig) / gsz; return true;
    }
    __device__ __forceinline__ void a_ready(const Unit&) const {}
    __device__ __forceinline__ void done(const Unit&) const {}
};

__device__ __forceinline__ unsigned cvt_pk_bf16(float lo, float hi) { unsigned r; asm volatile("v_cvt_pk_bf16_f32 %0, %1, %2" : "=v"(r) : "v"(lo), "v"(hi)); return r; }
typedef float f32x2 __attribute__((ext_vector_type(2)));
typedef unsigned u32x2 __attribute__((ext_vector_type(2)));
#define PG8_GAS __attribute__((address_space(1)))
constexpr float LOG2E = 1.4426950408889634f;
typedef unsigned long long u64;
constexpr float SSQ_FIX = 1048576.0f;
__device__ __forceinline__ float rstd_of(u64 q) { return rsqrtf((float)q * (1.0f / (SSQ_FIX * 1024.0f)) + 1e-6f); }
__device__ __forceinline__ float rstd_row(const u64* ssq, int row) { return rstd_of(((const PG8_GAS u64*)ssq)[row]); }
__device__ __forceinline__ float sigm(float a) { return __builtin_amdgcn_rcpf(1.0f + __builtin_amdgcn_exp2f(-a * LOG2E)); }
__device__ __forceinline__ void atomic_addf(u64* p, float v) { __hip_atomic_fetch_add((PG8_GAS u64*)p, (u64)(v * SSQ_FIX + 0.5f), __ATOMIC_RELAXED, __HIP_MEMORY_SCOPE_AGENT); }

struct EpiQK {
    static constexpr bool PERM = true, AFTER_DRAIN = false;
    bf16_t* O; int ldc; const u64* ssq; const float* bias; int qcols; float qscale;
    __device__ __forceinline__ void operator()(const f32x4 (&acc)[2][2][4][2], const Unit& u, int wr, int wc, int fr, int fq) const {
        const int row0 = u.pm * BM + wr * 64 + fr, col0 = u.pn * BM + wc * 32 + 8 * fq;
        const float sc = (u.pn * BM < qcols) ? qscale : 1.f;
        f32x4 bv[2][2];
#pragma unroll
        for (int bj = 0; bj < 2; ++bj)
#pragma unroll
            for (int n = 0; n < 2; ++n) bv[bj][n] = bias ? *(const PG8_GAS f32x4*)(bias + col0 + bj * HALF + 4 * n) : (f32x4){0.f, 0.f, 0.f, 0.f};
#pragma unroll
        for (int ai = 0; ai < 2; ++ai)
#pragma unroll
            for (int m = 0; m < 4; ++m) { const int row = row0 + ai * HALF + m * 16; const float rs = ssq ? rstd_row(ssq, row) : 1.f; bf16_t* rowp = O + (size_t)row * ldc + col0;
#pragma unroll
                for (int bj = 0; bj < 2; ++bj) { const f32x4 v0 = (acc[ai][bj][m][0] * rs + bv[bj][0]) * sc, v1 = (acc[ai][bj][m][1] * rs + bv[bj][1]) * sc;
                    u32x4 w; w.x = cvt_pk_bf16(v0[0], v0[1]); w.y = cvt_pk_bf16(v0[2], v0[3]); w.z = cvt_pk_bf16(v1[0], v1[1]); w.w = cvt_pk_bf16(v1[2], v1[3]);
                    *(PG8_GAS u32x4*)(rowp + bj * HALF) = w; } }
    }
};
struct EpiVT {
    static constexpr bool PERM = true, AFTER_DRAIN = false;
    bf16_t* O; int ldc; const u64* ssq; const float* bias;
    __device__ __forceinline__ void operator()(const f32x4 (&acc)[2][2][4][2], const Unit& u, int wr, int wc, int fr, int fq) const {
        const int row0 = u.pm * BM + wr * 64 + fr, col0 = u.pn * BM + wc * 32 + 8 * fq;
        f32x4 rs[2][2];
#pragma unroll
        for (int bj = 0; bj < 2; ++bj)
#pragma unroll
            for (int n = 0; n < 2; ++n) {
#pragma unroll
                for (int i = 0; i < 4; ++i) rs[bj][n][i] = rstd_of(((const PG8_GAS u64*)ssq)[col0 + bj * HALF + 4 * n + i]); }
#pragma unroll
        for (int ai = 0; ai < 2; ++ai)
#pragma unroll
            for (int m = 0; m < 4; ++m) { const int row = row0 + ai * HALF + m * 16; const float bb = bias ? ((const PG8_GAS float*)bias)[row] : 0.f; bf16_t* rowp = O + (size_t)row * ldc + col0;
#pragma unroll
                for (int bj = 0; bj < 2; ++bj) { const f32x4 v0 = acc[ai][bj][m][0] * rs[bj][0] + bb, v1 = acc[ai][bj][m][1] * rs[bj][1] + bb;
                    u32x4 w; w.x = cvt_pk_bf16(v0[0], v0[1]); w.y = cvt_pk_bf16(v0[2], v0[3]); w.z = cvt_pk_bf16(v1[0], v1[1]); w.w = cvt_pk_bf16(v1[2], v1[3]);
                    *(PG8_GAS u32x4*)(rowp + bj * HALF) = w; } }
    }
};
struct EpiResid {
    static constexpr bool PERM = true, AFTER_DRAIN = false;
    const bf16_t* base; bf16_t* hb; u64* ssq_next;
    __device__ __forceinline__ void operator()(const f32x4 (&acc)[2][2][4][2], const Unit& u, int wr, int wc, int fr, int fq) const {
        const int row0 = u.pm * BM + wr * 64 + fr, col0 = u.pn * BM + wc * 32 + 8 * fq;
#pragma unroll
        for (int ai = 0; ai < 2; ++ai) {
            u32x4 bs[4][2];
#pragma unroll
            for (int m = 0; m < 4; ++m) { const size_t off0 = (size_t)(row0 + ai * HALF + m * 16) * 1024 + col0;
#pragma unroll
                for (int bj = 0; bj < 2; ++bj) bs[m][bj] = *(const PG8_GAS u32x4*)(base + off0 + bj * HALF); }
            asm volatile("" ::: "memory");
            float ssm = 0.f;
#pragma unroll
            for (int m = 0; m < 4; ++m) { const int row = row0 + ai * HALF + m * 16; const size_t off0 = (size_t)row * 1024 + col0; float ss = 0.f;
#pragma unroll
                for (int bj = 0; bj < 2; ++bj) { const u32x4 bw = bs[m][bj]; f32x4 v0 = acc[ai][bj][m][0], v1 = acc[ai][bj][m][1];
                    v0[0] += __uint_as_float(bw.x << 16); v0[1] += __uint_as_float(bw.x & 0xffff0000u); v0[2] += __uint_as_float(bw.y << 16); v0[3] += __uint_as_float(bw.y & 0xffff0000u);
                    v1[0] += __uint_as_float(bw.z << 16); v1[1] += __uint_as_float(bw.z & 0xffff0000u); v1[2] += __uint_as_float(bw.w << 16); v1[3] += __uint_as_float(bw.w & 0xffff0000u);
                    u32x4 w; w.x = cvt_pk_bf16(v0[0], v0[1]); w.y = cvt_pk_bf16(v0[2], v0[3]); w.z = cvt_pk_bf16(v1[0], v1[1]); w.w = cvt_pk_bf16(v1[2], v1[3]);
                    *(PG8_GAS u32x4*)(hb + off0 + bj * HALF) = w;
                    ss += ((v0[0] * v0[0] + v0[1] * v0[1]) + (v0[2] * v0[2] + v0[3] * v0[3])) + ((v1[0] * v1[0] + v1[1] * v1[1]) + (v1[2] * v1[2] + v1[3] * v1[3])); }
                ss += __shfl_xor(ss, 16); ss += __shfl_xor(ss, 32);
                ssm = (fq == m) ? ss : ssm; }
            atomic_addf(ssq_next + row0 + ai * HALF + fq * 16, ssm);
            asm volatile("" ::: "memory");
        }
    }
};
struct EpiSwiGLU {
    static constexpr bool PERM = true, AFTER_DRAIN = false;
    bf16_t* O; const u64* ssq;
    __device__ __forceinline__ void operator()(const f32x4 (&acc)[2][2][4][2], const Unit& u, int wr, int wc, int fr, int fq) const {
        const int row0 = u.pm * BM + wr * 64 + fr, colh = u.pn * HALF + wc * 32 + 8 * fq;
#pragma unroll
        for (int ai = 0; ai < 2; ++ai)
#pragma unroll
            for (int m = 0; m < 4; ++m) { const int row = row0 + ai * HALF + m * 16; const float rs = rstd_row(ssq, row); f32x4 r[2];
#pragma unroll
                for (int n = 0; n < 2; ++n) { const f32x4 g = acc[ai][0][m][n] * rs, up = acc[ai][1][m][n] * rs;
#pragma unroll
                    for (int i = 0; i < 4; ++i) r[n][i] = g[i] * sigm(g[i]) * up[i]; }
                u32x4 w; w.x = cvt_pk_bf16(r[0][0], r[0][1]); w.y = cvt_pk_bf16(r[0][2], r[0][3]); w.z = cvt_pk_bf16(r[1][0], r[1][1]); w.w = cvt_pk_bf16(r[1][2], r[1][3]);
                *(PG8_GAS u32x4*)(O + (size_t)row * 2816 + colh) = w; }
    }
};
struct EpiPle {
    static constexpr bool PERM = true, AFTER_DRAIN = false;
    const bf16_t* hin; const bf16_t* proj; bf16_t* hb; const u64* ssq_in; u64* ssq_next;
    __device__ __forceinline__ void operator()(const f32x4 (&acc)[2][2][4][2], const Unit& u, int wr, int wc, int fr, int fq) const {
        const int row0 = u.pm * BM + wr * 64 + fr, col0 = u.pn * BM + wc * 32 + 8 * fq;
#pragma unroll
        for (int ai = 0; ai < 2; ++ai) {
            u32x4 hs[4][2], ps[4][2]; u64 sq[4];
#pragma unroll
            for (int m = 0; m < 4; ++m) { const int row = row0 + ai * HALF + m * 16; const size_t off0 = (size_t)row * 1024 + col0; sq[m] = ((const PG8_GAS u64*)ssq_in)[row];
#pragma unroll
                for (int bj = 0; bj < 2; ++bj) { hs[m][bj] = *(const PG8_GAS u32x4*)(hin + off0 + bj * HALF); ps[m][bj] = *(const PG8_GAS u32x4*)(proj + off0 + bj * HALF); } }
            asm volatile("" ::: "memory");
            float ssm = 0.f;
#pragma unroll
            for (int m = 0; m < 4; ++m) { const int row = row0 + ai * HALF + m * 16; const size_t off0 = (size_t)row * 1024 + col0; const float rs = rstd_of(sq[m]); float ss = 0.f;
#pragma unroll
                for (int bj = 0; bj < 2; ++bj) { const u32x4 pw = ps[m][bj], hw = hs[m][bj]; u32x4 w;
#pragma unroll
                    for (int n = 0; n < 2; ++n) { const f32x4 a = acc[ai][bj][m][n] * rs; const unsigned p0 = n ? pw.z : pw.x, p1 = n ? pw.w : pw.y, h0 = n ? hw.z : hw.x, h1 = n ? hw.w : hw.y;
                        f32x4 v; v[0] = __uint_as_float(h0 << 16) + sigm(a[0]) * __uint_as_float(p0 << 16); v[1] = __uint_as_float(h0 & 0xffff0000u) + sigm(a[1]) * __uint_as_float(p0 & 0xffff0000u);
                        v[2] = __uint_as_float(h1 << 16) + sigm(a[2]) * __uint_as_float(p1 << 16); v[3] = __uint_as_float(h1 & 0xffff0000u) + sigm(a[3]) * __uint_as_float(p1 & 0xffff0000u);
                        const unsigned c0 = cvt_pk_bf16(v[0], v[1]), c1 = cvt_pk_bf16(v[2], v[3]); if (n) { w.z = c0; w.w = c1; } else { w.x = c0; w.y = c1; }
                        ss += (v[0] * v[0] + v[1] * v[1]) + (v[2] * v[2] + v[3] * v[3]); }
                    *(PG8_GAS u32x4*)(hb + off0 + bj * HALF) = w; }
                ss += __shfl_xor(ss, 16); ss += __shfl_xor(ss, 32);
                ssm = (fq == m) ? ss : ssm; }
            atomic_addf(ssq_next + row0 + ai * HALF + fq * 16, ssm);
            asm volatile("" ::: "memory");
        }
    }
};
template <class Epi, class Sched, bool ALIGN_EPI = false, bool SP2 = false>
__device__ __forceinline__ void gemm_phase(PG8_LAS unsigned char* lds, const Gemm g, const Sched& S, const Epi& E) {
    int tid_ = threadIdx.x; asm volatile("" : "+v"(tid_));
    const int tid = tid_, wid = __builtin_amdgcn_readfirstlane(tid >> 6), lane = tid & 63, wr = wid >> 2, wc = wid & 3, fr = lane & 15, fq = lane >> 4;
    const int K = g.K, nt = K / BK;
    unsigned voffA[2], voffB[2];
#pragma unroll
    for (int i = 0; i < 2; ++i) { int R, C; stage_rc(tid * 16 + i * 8192, R, C); const int Rb = Epi::PERM ? ((R & ~31) + perm32(R & 31)) : R;
        voffA[i] = (unsigned)(R * K + C) * 2u; voffB[i] = (unsigned)(Rb * K + C) * 2u; }
    const size_t kstep = (size_t)(BK * 2);
    const size_t hstep = (size_t)HALF * K * 2;
    const size_t tstep = 2 * hstep;
    const unsigned ldsw = (unsigned)wid * 1024u;
    const int aoff = lds_byte(wr * 64 + fr, fq * 8), boff = lds_byte(wc * 32 + fr, fq * 8);
#define PG8_SA(b, h) (((b) * 2 + (h)) * HTB)
#define PG8_SB(b, h) ((4 + (b) * 2 + (h)) * HTB)
#define PG8_STAGE(bufoff, gbase, voff) do { _Pragma("unroll") for (int _i = 0; _i < 2; ++_i) \
        __builtin_amdgcn_global_load_lds((const unsigned*)((const char*)(gbase) + (voff)[_i]), (PG8_LAS unsigned*)(lds + (bufoff) + ldsw + _i * 8192), 16, 0, 0); } while (0)
#define PG8_LDA(dst, b, h) do { _Pragma("unroll") for (int m = 0; m < 4; ++m) _Pragma("unroll") for (int k = 0; k < 2; ++k) dst[m][k] = *(const PG8_LAS bf16x8*)(lds + PG8_SA(b, h) + aoff + m * 2048 + k * 1024); } while (0)
#define PG8_LDB(dst, b, h) do { _Pragma("unroll") for (int n = 0; n < 2; ++n) _Pragma("unroll") for (int k = 0; k < 2; ++k) dst[n][k] = *(const PG8_LAS bf16x8*)(lds + PG8_SB(b, h) + boff + n * 2048 + k * 1024); } while (0)
#define PG8_MMA(ai, bj, At, Bt) do { __builtin_amdgcn_s_setprio(1); _Pragma("unroll") for (int m = 0; m < 4; ++m) _Pragma("unroll") for (int n = 0; n < 2; ++n) _Pragma("unroll") for (int k = 0; k < 2; ++k) \
        acc[ai][bj][m][n] = __builtin_amdgcn_mfma_f32_16x16x32_bf16(Bt[n][k], At[m][k], acc[ai][bj][m][n], 0, 0, 0); __builtin_amdgcn_s_setprio(0); } while (0)
#define PG8_WAIT_V(n) asm volatile("s_waitcnt vmcnt(" #n ")" ::: "memory")
#define PG8_WAIT_L(n) asm volatile("s_waitcnt lgkmcnt(" #n ")" ::: "memory")
#define PG8_BAR __builtin_amdgcn_s_barrier()
#define PG8_SCHED __builtin_amdgcn_sched_barrier(0)
    Unit cur, nxt; int ui = 0;
    if (!S.next(0, cur)) return;
    f32x4 acc[2][2][4][2];
#pragma unroll
    for (int a = 0; a < 2; ++a)
#pragma unroll
        for (int b = 0; b < 2; ++b)
#pragma unroll
            for (int m = 0; m < 4; ++m)
#pragma unroll
                for (int n = 0; n < 2; ++n) acc[a][b][m][n] = (f32x4){0.f, 0.f, 0.f, 0.f};
    bf16x8 At[4][2], B0[2][2], B1[2][2];
    const char* cA = (const char*)g.A + (size_t)cur.pm * tstep; const char* cB = (const char*)g.Bt + (size_t)cur.pn * tstep;
    S.a_ready(cur);
    if constexpr (SP2) {
        PG8_STAGE(PG8_SB(0, 0), cB, voffB); PG8_STAGE(PG8_SB(0, 1), cB + hstep, voffB); PG8_STAGE(PG8_SA(0, 0), cA, voffA); PG8_STAGE(PG8_SA(0, 1), cA + hstep, voffA);
        if (wr == 1) PG8_BAR;
        PG8_WAIT_V(2); PG8_BAR;
        PG8_STAGE(PG8_SB(1, 0), cB + kstep, voffB); PG8_STAGE(PG8_SA(1, 0), cA + kstep, voffA); PG8_STAGE(PG8_SB(1, 1), cB + hstep + kstep, voffB);
        PG8_WAIT_V(6); PG8_BAR;
    } else {
        PG8_STAGE(PG8_SB(0, 0), cB, voffB); PG8_STAGE(PG8_SA(0, 0), cA, voffA); PG8_STAGE(PG8_SB(0, 1), cB + hstep, voffB); PG8_STAGE(PG8_SA(0, 1), cA + hstep, voffA);
        if (wr == 1) PG8_BAR;
        PG8_WAIT_V(4); PG8_BAR;
        PG8_STAGE(PG8_SB(1, 0), cB + kstep, voffB); PG8_STAGE(PG8_SA(1, 0), cA + kstep, voffA); PG8_STAGE(PG8_SB(1, 1), cB + hstep + kstep, voffB);
        PG8_WAIT_V(6); PG8_BAR;
    }
    for (;;) {
        const bool has_next = S.next(ui + 1, nxt);
        const char* nA = has_next ? (const char*)g.A + (size_t)nxt.pm * tstep : cA; const char* nB = has_next ? (const char*)g.Bt + (size_t)nxt.pn * tstep : cB;
        for (int t = 0; t < nt; t += 2) {
            const bool last = (t == nt - 2);
            const char* a1 = cA + (size_t)(t + 1) * kstep;
            const char* a2 = last ? nA : cA + (size_t)(t + 2) * kstep; const char* b2 = last ? nB : cB + (size_t)(t + 2) * kstep;
            const char* a3 = a2 + kstep; const char* b3 = b2 + kstep;
            if (last && has_next) S.a_ready(nxt);
            if constexpr (SP2) {
            PG8_LDB(B0, 0, 0); PG8_LDB(B1, 0, 1); PG8_SCHED; PG8_LDA(At, 0, 0); PG8_STAGE(PG8_SA(1, 1), a1 + hstep, voffA);
            PG8_WAIT_V(8); PG8_WAIT_L(0); PG8_BAR; PG8_MMA(0, 0, At, B0); PG8_MMA(0, 1, At, B1); PG8_BAR; PG8_SCHED;
            PG8_LDA(At, 0, 1); PG8_STAGE(PG8_SB(0, 0), b2, voffB); PG8_STAGE(PG8_SB(0, 1), b2 + hstep, voffB); PG8_STAGE(PG8_SA(0, 0), a2, voffA);
            PG8_WAIT_V(8); PG8_WAIT_L(0); PG8_BAR; PG8_MMA(1, 0, At, B0); PG8_MMA(1, 1, At, B1); PG8_BAR; PG8_SCHED;
            PG8_LDB(B0, 1, 0); PG8_LDB(B1, 1, 1); PG8_SCHED; PG8_LDA(At, 1, 0); PG8_STAGE(PG8_SA(0, 1), a2 + hstep, voffA);
            PG8_WAIT_V(8); PG8_WAIT_L(0); PG8_BAR; PG8_MMA(0, 0, At, B0); PG8_MMA(0, 1, At, B1); PG8_BAR; PG8_SCHED;
            PG8_LDA(At, 1, 1); PG8_STAGE(PG8_SB(1, 0), b3, voffB); PG8_STAGE(PG8_SB(1, 1), b3 + hstep, voffB); PG8_STAGE(PG8_SA(1, 0), a3, voffA);
            PG8_WAIT_V(8); PG8_WAIT_L(0); PG8_BAR; PG8_MMA(1, 0, At, B0); PG8_MMA(1, 1, At, B1); PG8_BAR; PG8_SCHED;
            } else {
            PG8_LDB(B0, 0, 0); PG8_SCHED; PG8_LDA(At, 0, 0); PG8_STAGE(PG8_SA(1, 1), a1 + hstep, voffA);
            PG8_WAIT_L(8); PG8_BAR; PG8_WAIT_L(0); PG8_MMA(0, 0, At, B0); PG8_BAR; PG8_SCHED;
            PG8_LDB(B1, 0, 1); PG8_STAGE(PG8_SB(0, 0), b2, voffB);
            PG8_BAR; PG8_WAIT_L(0); PG8_MMA(0, 1, At, B1); PG8_BAR;
            PG8_LDA(At, 0, 1); PG8_STAGE(PG8_SA(0, 0), a2, voffA);
            PG8_BAR; PG8_WAIT_L(0); PG8_MMA(1, 0, At, B0); PG8_BAR; PG8_SCHED;
            PG8_STAGE(PG8_SB(0, 1), b2 + hstep, voffB);
            PG8_WAIT_V(6); PG8_BAR; PG8_MMA(1, 1, At, B1); PG8_BAR;
            PG8_LDB(B0, 1, 0); PG8_SCHED; PG8_LDA(At, 1, 0); PG8_STAGE(PG8_SA(0, 1), a2 + hstep, voffA);
            PG8_WAIT_L(8); PG8_BAR; PG8_WAIT_L(0); PG8_MMA(0, 0, At, B0); PG8_BAR; PG8_SCHED;
            PG8_LDB(B1, 1, 1); PG8_STAGE(PG8_SB(1, 0), b3, voffB);
            PG8_BAR; PG8_WAIT_L(0); PG8_MMA(0, 1, At, B1); PG8_BAR;
            PG8_LDA(At, 1, 1); PG8_STAGE(PG8_SA(1, 0), a3, voffA);
            PG8_BAR; PG8_WAIT_L(0); PG8_MMA(1, 0, At, B0); PG8_BAR; PG8_SCHED;
            PG8_STAGE(PG8_SB(1, 1), b3 + hstep, voffB);
            PG8_WAIT_V(6); PG8_BAR; PG8_MMA(1, 1, At, B1); PG8_BAR;
            }
        }
        if constexpr (ALIGN_EPI) { if (wr == 0) PG8_BAR; }
        if constexpr (!Epi::AFTER_DRAIN) { E(acc, cur, wr, wc, fr, fq); S.done(cur); }
        if (!has_next) break;
#pragma unroll
        for (int a = 0; a < 2; ++a)
#pragma unroll
            for (int b = 0; b < 2; ++b)
#pragma unroll
                for (int m = 0; m < 4; ++m)
#pragma unroll
                    for (int n = 0; n < 2; ++n) acc[a][b][m][n] = (f32x4){0.f, 0.f, 0.f, 0.f};
        cur = nxt; cA = nA; cB = nB; ++ui;
        if constexpr (ALIGN_EPI) { if (wr == 1) PG8_BAR; }
    }
    PG8_WAIT_V(0);
    if constexpr (!ALIGN_EPI) { if (wr == 0) PG8_BAR; }
    PG8_BAR;
    if constexpr (Epi::AFTER_DRAIN) { E.fused(acc, cur, wr, wc, fr, fq, lds, wid, lane); S.done(cur); }
#undef PG8_SA
#undef PG8_SB
#undef PG8_STAGE
#undef PG8_LDA
#undef PG8_LDB
#undef PG8_MMA
#undef PG8_WAIT_V
#undef PG8_WAIT_L
#undef PG8_BAR
#undef PG8_SCHED
}
}
namespace att {
#define LAS __attribute__((address_space(3)))
typedef unsigned short bf16_t;
typedef short bf16x8 __attribute__((ext_vector_type(8)));
typedef float f32x4 __attribute__((ext_vector_type(4)));
typedef float f32x16 __attribute__((ext_vector_type(16)));
typedef unsigned u32x4 __attribute__((ext_vector_type(4)));
typedef unsigned u32x2 __attribute__((ext_vector_type(2)));
typedef float f32x2_t __attribute__((ext_vector_type(2))); typedef __bf16 bf16x2_t __attribute__((ext_vector_type(2)));
constexpr float LOG2E = 1.4426950408889634f;
constexpr int SEQ = 4096, MTOK = 65536;
__device__ __forceinline__ unsigned cvtpk(float lo, float hi) { f32x2_t v = {lo, hi}; bf16x2_t b = __builtin_convertvector(v, bf16x2_t); return __builtin_bit_cast(unsigned, b); }

#define GAS __attribute__((address_space(1)))
__device__ __forceinline__ void da_knorm(const bf16_t* QK_, float* kn_, int gw, int NGW, int lane) {
    const GAS bf16_t* QK = (const GAS bf16_t*)QK_; GAS float* kn = (GAS float*)kn_;
    for (int task = gw; task < 16 * 8 * 64; task += NGW) {
        const int b = task >> 9, h = (task >> 6) & 7, t = task & 63;
        const GAS u32x4* p = (const GAS u32x4*)(QK + ((size_t)b * SEQ + t * 64 + lane) * 2048 + 1024 + h * 128);
        float a[2] = {0.f, 0.f};
#pragma unroll
        for (int c = 0; c < 16; ++c) { const u32x4 w = p[c];
#pragma unroll
            for (int i = 0; i < 4; ++i) { const float lo = __uint_as_float(w[i] << 16), hi = __uint_as_float(w[i] & 0xffff0000u); a[c >> 3] += lo * lo + hi * hi; } }
        float m = __builtin_fmaxf(a[0], a[1]);
#pragma unroll
        for (int o = 1; o < 64; o <<= 1) m = __builtin_fmaxf(m, __shfl_xor(m, o));
        if (lane == 0) kn[task] = __builtin_sqrtf(m) * 1.002f;
    }
}
__device__ __forceinline__ void da_phase(LAS unsigned char* lds, const bf16_t* QK_, const bf16_t* VT_, bf16_t* AO_, const float* kn_,
                                         float lam, float outscale, const float* subln_, int G, int bx) {
    int tid_ = threadIdx.x; asm volatile("" : "+v"(tid_));
    const int tid = tid_, lane = tid & 63, wid = __builtin_amdgcn_readfirstlane(tid >> 6), q = lane & 31, hi = lane >> 5, mp = wid >> 2, wq = wid & 3;
    const GAS bf16_t* QK = (const GAS bf16_t*)QK_; const GAS bf16_t* VT = (const GAS bf16_t*)VT_; GAS bf16_t* AO = (GAS bf16_t*)AO_; const GAS float* kn = (const GAS float*)kn_; const GAS float* subln = (const GAS float*)subln_;
    const int pi = (q & ~12) | ((q & 8) >> 1) | ((q & 4) << 1);
    unsigned rk[4], rv[4];
#pragma unroll
    for (int s = 0; s < 4; ++s) { const int ck = 2 * s + hi; rk[s] = mp * 8192 + ck * 1024 + (pi ^ ck) * 16; }
#pragma unroll
    for (int jv = 0; jv < 4; ++jv) { const int cv = 2 * jv + hi; rv[jv] = 16384 + cv * 2048 + (q ^ cv) * 16; }
    const int kr = tid >> 4, kch = tid & 15, vd = tid >> 3, vc = tid & 7;
    const unsigned kdst = (kch >> 3) * 8192 + (kch & 7) * 1024 + (kr ^ (kch & 7)) * 16, vdst = 16384 + vc * 2048 + (vd ^ vc) * 16;
    LAS float* xch = (LAS float*)(lds + 65536) + wq * 4096 + lane;
    LAS float* red = (LAS float*)(lds + 131072);
    for (int un = bx; un < 4096; un += G) {
        int b, h, qb; if (G == 256) { const int k = un >> 8; b = k; h = (bx + k) & 7; qb = ((bx >> 3) + 16 * (k & 1)) & 31; } else { b = un >> 8; h = (un >> 5) & 7; qb = un & 31; }
        const float nslope2 = -__builtin_amdgcn_exp2f(-(float)(h + 1)) * LOG2E;
        const size_t tokb = (size_t)b * SEQ;
        const int qpos = qb * 128 + wq * 32 + q;
        const GAS bf16_t* ksrc = QK + (tokb + kr) * 2048 + 1024 + h * 128 + kch * 8;
        const GAS bf16_t* vsrc = VT + (size_t)(h * 128 + vd) * MTOK + tokb + vc * 8;
        u32x4 sa0, sa1, sa2, sa3, sb0, sb1, sb2, sb3;
#define DA_LOADT(S, t) do { S##0 = *(const GAS u32x4*)(ksrc + (size_t)(t) * 64 * 2048); S##1 = *(const GAS u32x4*)(ksrc + (size_t)(t) * 64 * 2048 + 32 * 2048); \
                         S##2 = *(const GAS u32x4*)(vsrc + (t) * 64); S##3 = *(const GAS u32x4*)(vsrc + (size_t)64 * MTOK + (t) * 64); } while (0)
#define DA_STORET(S, bo) do { *(LAS u32x4*)(lds + (bo) + kdst) = S##0; *(LAS u32x4*)(lds + (bo) + kdst + 512) = S##1; *(LAS u32x4*)(lds + (bo) + vdst) = S##2; *(LAS u32x4*)(lds + (bo) + vdst + 1024) = S##3; } while (0)
        const int d0 = 2 * qb, d1 = 2 * qb + 1;
        DA_LOADT(sa, d0); DA_LOADT(sb, d1);
        bf16x8 qf[4]; float qn2 = 0.f;
        { const GAS bf16_t* qp = QK + (tokb + qpos) * 2048 + h * 128 + mp * 64 + 8 * hi;
#pragma unroll
          for (int s = 0; s < 4; ++s) { qf[s] = *(const GAS bf16x8*)(qp + 16 * s);
#pragma unroll
              for (int i = 0; i < 8; ++i) { const float v = __uint_as_float(((unsigned)(unsigned short)qf[s][i]) << 16); qn2 += v * v; } } }
        qn2 += __shfl_xor(qn2, 32);
        const float knl = kn[(b * 8 + h) * 64 + lane];
        f32x16 o[4];
#pragma unroll
        for (int d = 0; d < 4; ++d) o[d] = f32x16{};
        float mref = 0.f, l = 0.f;
#define DA_COMPUTE(t, bo, FIRST, LIN) do { \
            f32x16 p[2]; \
            const float dbase = (float)((t) * 64 + 8 * hi - qpos); \
            const float sg_ = ((t) < d0) ? -nslope2 : nslope2, A_ = dbase * sg_ - mref;     \
            _Pragma("unroll") for (int hf = 0; hf < 2; ++hf) { \
                if (LIN) { _Pragma("unroll") for (int r = 0; r < 16; ++r) p[hf][r] = __builtin_fmaf((float)(32 * hf + 16 * (r >> 3) + (r & 7)), sg_, A_); } \
                else { _Pragma("unroll") for (int r = 0; r < 16; ++r) p[hf][r] = __builtin_fmaf(__builtin_fabsf(dbase + (float)(32 * hf + 16 * (r >> 3) + (r & 7))), nslope2, -mref); } } \
              \
            _Pragma("unroll") for (int s = 0; s < 4; ++s) _Pragma("unroll") for (int hf = 0; hf < 2; ++hf) { \
                const bf16x8 kf = *(const LAS bf16x8*)(lds + (bo) + rk[s] + hf * 512); p[hf] = __builtin_amdgcn_mfma_f32_32x32x16_bf16(kf, qf[s], p[hf], 0, 0, 0); } \
            float mx = p[0][0]; \
            _Pragma("unroll") for (int r = 1; r < 16; ++r) mx = __builtin_fmaxf(mx, p[0][r]); \
            _Pragma("unroll") for (int r = 0; r < 16; ++r) mx = __builtin_fmaxf(mx, p[1][r]); \
            mx = __builtin_fmaxf(mx, __shfl_xor(mx, 32)); \
              \
            if (!(FIRST) && !__any(mx > -36.0f)) break; \
            if (FIRST) { mref = mx; \
                _Pragma("unroll") for (int r = 0; r < 16; ++r) { p[0][r] -= mx; p[1][r] -= mx; } } \
            else if (__any(mx > 8.0f)) { const float dl = __builtin_fmaxf(mx, 0.f); mref += dl; const float f = __builtin_amdgcn_exp2f(-dl); l *= f; \
                _Pragma("unroll") for (int r = 0; r < 16; ++r) { p[0][r] -= dl; p[1][r] -= dl; } \
                _Pragma("unroll") for (int d = 0; d < 4; ++d) _Pragma("unroll") for (int r = 0; r < 16; ++r) o[d][r] *= f; } \
              \
            float sacc = 0.f; bf16x8 pf[2][2]; \
            _Pragma("unroll") for (int r = 0; r < 16; ++r) { p[0][r] = __builtin_amdgcn_exp2f(p[0][r]); sacc += p[0][r]; } \
            _Pragma("unroll") for (int u = 0; u < 2; ++u) { u32x4 w; w.x = cvtpk(p[0][8 * u], p[0][8 * u + 1]); w.y = cvtpk(p[0][8 * u + 2], p[0][8 * u + 3]); \
                    w.z = cvtpk(p[0][8 * u + 4], p[0][8 * u + 5]); w.w = cvtpk(p[0][8 * u + 6], p[0][8 * u + 7]); pf[0][u] = __builtin_bit_cast(bf16x8, w); } \
            _Pragma("unroll") for (int u = 0; u < 2; ++u) _Pragma("unroll") for (int d = 0; d < 4; ++d) { \
                    const bf16x8 vf = *(const LAS bf16x8*)(lds + (bo) + rv[u] + d * 512); o[d] = __builtin_amdgcn_mfma_f32_32x32x16_bf16(vf, pf[0][u], o[d], 0, 0, 0); } \
            _Pragma("unroll") for (int r = 0; r < 16; ++r) { p[1][r] = __builtin_amdgcn_exp2f(p[1][r]); sacc += p[1][r]; } \
            _Pragma("unroll") for (int u = 0; u < 2; ++u) { u32x4 w; w.x = cvtpk(p[1][8 * u], p[1][8 * u + 1]); w.y = cvtpk(p[1][8 * u + 2], p[1][8 * u + 3]); \
                    w.z = cvtpk(p[1][8 * u + 4], p[1][8 * u + 5]); w.w = cvtpk(p[1][8 * u + 6], p[1][8 * u + 7]); pf[1][u] = __builtin_bit_cast(bf16x8, w); } \
            _Pragma("unroll") for (int i_ = 0; i_ < 8; ++i_) { __builtin_amdgcn_sched_group_barrier(0x100, 1, 0); __builtin_amdgcn_sched_group_barrier(0x008, 1, 0); __builtin_amdgcn_sched_group_barrier(0x002, 5, 0); } \
            l += sacc; \
            _Pragma("unroll") for (int u = 0; u < 2; ++u) _Pragma("unroll") for (int d = 0; d < 4; ++d) { \
                    const bf16x8 vf = *(const LAS bf16x8*)(lds + (bo) + rv[2 + u] + d * 512); o[d] = __builtin_amdgcn_mfma_f32_32x32x16_bf16(vf, pf[1][u], o[d], 0, 0, 0); } \
        } while (0)
        DA_STORET(sa, 0);
        __syncthreads();
        DA_COMPUTE(d0, 0, true, false);
        DA_STORET(sb, 32768);
        __syncthreads();
        DA_COMPUTE(d1, 32768, false, false);
        { float lmin = mref, qmx = qn2;
#pragma unroll
          for (int o_ = 1; o_ < 64; o_ <<= 1) { lmin = __builtin_fminf(lmin, __shfl_xor(lmin, o_)); qmx = __builtin_fmaxf(qmx, __shfl_xor(qmx, o_)); }
          if (lane == 0) { red[2 * wid] = lmin; red[2 * wid + 1] = qmx; } }
        __syncthreads();
        unsigned long long mask;
        { float Lmin = red[0], Q2 = red[1];
#pragma unroll
          for (int w = 1; w < 8; ++w) { Lmin = __builtin_fminf(Lmin, red[2 * w]); Q2 = __builtin_fmaxf(Q2, red[2 * w + 1]); }
          const float Qmax = __builtin_sqrtf(Q2) * 1.002f;
          const int t = lane, mind = (t < d0) ? (qb * 128 - (t * 64 + 63)) : (t * 64 - (qb * 128 + 127));
          const float bound = Qmax * knl + nslope2 * (float)mind;
          const bool need = (t != d0) && (t != d1) && (bound >= Lmin - 36.0f);
          mask = __ballot(need); }
        if (mask) {
#define DA_POP(v) do { v = -1; if (mask) { v = (int)__builtin_ctzll(mask); mask &= mask - 1; } } while (0)
            int cur, n1, n2; DA_POP(cur); DA_POP(n1);
            unsigned bo = 0;
            DA_LOADT(sa, cur); DA_LOADT(sb, (n1 >= 0 ? n1 : cur));
            DA_STORET(sa, 0);
            __syncthreads();
#define DA_STEP(X, Y) { DA_POP(n2); DA_LOADT(Y, (n2 >= 0 ? n2 : cur)); DA_COMPUTE(cur, bo, false, true); if (n1 < 0) break; DA_STORET(X, bo ^ 32768); __syncthreads(); bo ^= 32768; cur = n1; n1 = n2; }
            for (;;) { DA_STEP(sb, sa) DA_STEP(sa, sb) }
#undef DA_STEP
#undef DA_POP
        }
        __syncthreads();
#undef DA_LOADT
#undef DA_STORET
#undef DA_COMPUTE
        l += __shfl_xor(l, 32);
        const float inv = 1.0f / l;
        if (mp == 1) {
#pragma unroll
            for (int d = 0; d < 4; ++d)
#pragma unroll
                for (int r = 0; r < 16; ++r) xch[(d * 16 + r) * 64] = o[d][r] * inv;
        }
        __syncthreads();
        if (mp == 0) {
            float ss = 0.f;
#pragma unroll
            for (int d = 0; d < 4; ++d)
#pragma unroll
                for (int r = 0; r < 16; ++r) { const float v = o[d][r] * inv - lam * xch[(d * 16 + r) * 64]; o[d][r] = v; ss += v * v; }
            ss += __shfl_xor(ss, 32);
            const float rs = rsqrtf(ss * (1.0f / 128.0f) + 1e-5f) * outscale;
            GAS bf16_t* op = AO + (tokb + qpos) * 1024 + h * 128 + 4 * hi;
#pragma unroll
            for (int d = 0; d < 4; ++d)
#pragma unroll
                for (int r4 = 0; r4 < 4; ++r4) { const f32x4 g = *(const GAS f32x4*)(subln + 32 * d + 8 * r4 + 4 * hi);
                    u32x2 w; w.x = cvtpk(o[d][4 * r4] * rs * g[0], o[d][4 * r4 + 1] * rs * g[1]); w.y = cvtpk(o[d][4 * r4 + 2] * rs * g[2], o[d][4 * r4 + 3] * rs * g[3]);
                    *(GAS u32x2*)(op + 32 * d + 8 * r4) = w; }
        }
    }
}
#undef GAS

#define GAS __attribute__((address_space(1)))
constexpr int NA_RING = 147456, NA_TB = NA_RING;
__device__ __forceinline__ void na_phase(LAS unsigned char* lds, const bf16_t* QK_, const bf16_t* VT_, bf16_t* AO_, const float* rpb_, int G, int bx) {
    int tid_ = threadIdx.x; asm volatile("" : "+v"(tid_));
    const int tid = tid_, lane = tid & 63, wid = __builtin_amdgcn_readfirstlane(tid >> 6), n = lane & 15, g = lane >> 4;
    const GAS bf16_t* QK = (const GAS bf16_t*)QK_; const GAS bf16_t* VT = (const GAS bf16_t*)VT_; GAS bf16_t* AO = (GAS bf16_t*)AO_; const GAS float* rpb = (const GAS float*)rpb_;
    LAS float* tb = (LAS float*)(lds + NA_TB);
    const int rq = wid >> 2, qg = wid & 3, c0 = 16 * qg, cw0 = (qg == 0) ? 0 : (qg == 1) ? 8 : (qg == 2) ? 24 : 32;
    const int c = c0 + n, cs = min(max(c - 8, 0), 48);
    unsigned ka[2], va[2];
#pragma unroll
    for (int ks = 0; ks < 2; ++ks) ka[ks] = (cw0 + n) * 128 + (((4 * ks + g) ^ (n & 7)) * 16);
    { const int c8 = (cw0 >> 2) + g; va[0] = 8192 + n * 128 + (((c8 >> 1) ^ (n & 7)) * 16) + (c8 & 1) * 8; va[1] = 8192 + n * 128 + ((((c8 >> 1) + 2) ^ (n & 7)) * 16) + (c8 & 1) * 8; }
    const int tr = tid >> 3, tc = tid & 7;
    const unsigned sdst = tr * 128 + ((tc ^ (tr & 7)) * 16);
    int bidx[8]; unsigned vmask = 0;
#pragma unroll
    for (int j8 = 0; j8 < 8; ++j8) { const int kc = cw0 + 16 * (j8 >> 2) + 4 * g + (j8 & 3); bidx[j8] = min(max(kc - c + 15, 0), 30); vmask |= ((unsigned)(kc - cs) < 16u) ? (1u << j8) : 0u; }
    for (int un = bx; un < 256; un += G) {
        const int b = un >> 4, h = un & 15;
        __syncthreads();
        for (int i = tid; i < 15 * 31; i += 512) tb[i] = rpb[h * 465 + i] * LOG2E;
        const GAS bf16_t* ksrc = QK + ((size_t)b * SEQ + tr) * 2048 + 1024 + h * 64 + tc * 8;
        const GAS bf16_t* vsrc = VT + (size_t)(h * 64 + tr) * MTOK + (size_t)b * SEQ + tc * 8;
#define NA_LDK(row) (*(const GAS u32x4*)(ksrc + (size_t)(row) * 64 * 2048))
#define NA_LDV(row) (*(const GAS u32x4*)(vsrc + (row) * 64))
#define NA_ST(row, kv, vv_) do { const unsigned so_ = (unsigned)((row) % 9) * 16384u + sdst; *(LAS u32x4*)(lds + so_) = (kv); *(LAS u32x4*)(lds + so_ + 8192) = (vv_); } while (0)
#pragma unroll
        for (int row = 0; row < 8; row += 4) { const u32x4 a0 = NA_LDK(row), b0 = NA_LDV(row), a1 = NA_LDK(row + 1), b1 = NA_LDV(row + 1), a2 = NA_LDK(row + 2), b2 = NA_LDV(row + 2), a3 = NA_LDK(row + 3), b3 = NA_LDV(row + 3);
            NA_ST(row, a0, b0); NA_ST(row + 1, a1, b1); NA_ST(row + 2, a2, b2); NA_ST(row + 3, a3, b3); }
        int loaded_hi = 7;
        const GAS bf16_t* qbase = QK + ((size_t)b * SEQ + rq * 64 + c0 + n) * 2048 + h * 64 + 8 * g;
        bf16x8 q0 = *(const GAS bf16x8*)qbase, q1 = *(const GAS bf16x8*)(qbase + 32);
        __syncthreads();
        for (int s = 0; s < 32; ++s) {
            const int tgt = (s < 31) ? (min(max(2 * s - 1, 0), 56) + 7) : loaded_hi;
            const int nnew = tgt - loaded_hi;
            const int ra_ = min(loaded_hi + 1, 63), rb_ = min(loaded_hi + 2, 63);
            const u32x4 p0 = NA_LDK(ra_), p1 = NA_LDV(ra_), p2 = NA_LDK(rb_), p3 = NA_LDV(rb_);
            const int sn = (s < 31) ? s + 1 : s;
            const bf16x8 q0n = *(const GAS bf16x8*)(qbase + (size_t)sn * 128 * 2048), q1n = *(const GAS bf16x8*)(qbase + (size_t)sn * 128 * 2048 + 32);
            const int r = 2 * s + rq, rs = min(max(r - 4, 0), 56);
            const int slot0 = rs % 9;
            float bvl[8][8];
#pragma unroll
            for (int kr = 0; kr < 8; ++kr) { const LAS float* rowp = tb + (rs + kr - r + 7) * 31;
#pragma unroll
                for (int j8 = 0; j8 < 8; ++j8) bvl[kr][j8] = rowp[bidx[j8]]; }
            __builtin_amdgcn_sched_group_barrier(0x100, 64, 0);
            f32x4 st[16];
#pragma unroll
            for (int kp = 0; kp < 4; ++kp) {
                bf16x8 kf[2][2][2];
#pragma unroll
                for (int k2 = 0; k2 < 2; ++k2) { int sl = slot0 + 2 * kp + k2; sl = (sl >= 9) ? sl - 9 : sl; const unsigned base = (unsigned)sl * 16384u;
#pragma unroll
                    for (int hf = 0; hf < 2; ++hf) { kf[k2][hf][0] = *(const LAS bf16x8*)(lds + base + hf * 2048 + ka[0]); kf[k2][hf][1] = *(const LAS bf16x8*)(lds + base + hf * 2048 + ka[1]); } }
#pragma unroll
                for (int k2 = 0; k2 < 2; ++k2)
#pragma unroll
                    for (int hf = 0; hf < 2; ++hf) { f32x4 a = __builtin_amdgcn_mfma_f32_16x16x32_bf16(kf[k2][hf][0], q0, (f32x4){0.f, 0.f, 0.f, 0.f}, 0, 0, 0);
                        st[(2 * kp + k2) * 2 + hf] = __builtin_amdgcn_mfma_f32_16x16x32_bf16(kf[k2][hf][1], q1, a, 0, 0, 0); }
                __builtin_amdgcn_sched_group_barrier(0x100, 8, 0); __builtin_amdgcn_sched_group_barrier(0x008, 8, 0);
            }
            float mx = -INFINITY;
#pragma unroll
            for (int kr = 0; kr < 8; ++kr)
#pragma unroll
                for (int j8 = 0; j8 < 8; ++j8) { const float v = ((vmask >> j8) & 1u) ? st[kr * 2 + (j8 >> 2)][j8 & 3] + bvl[kr][j8] : -INFINITY; st[kr * 2 + (j8 >> 2)][j8 & 3] = v; mx = __builtin_fmaxf(mx, v); }
            mx = __builtin_fmaxf(mx, __shfl_xor(mx, 16)); mx = __builtin_fmaxf(mx, __shfl_xor(mx, 32));
            float l = 0.f;
#pragma unroll
            for (int ti = 0; ti < 16; ++ti)
#pragma unroll
                for (int i = 0; i < 4; ++i) { const float e = __builtin_amdgcn_exp2f(st[ti][i] - mx); st[ti][i] = e; l += e; }
            l += __shfl_xor(l, 16); l += __shfl_xor(l, 32);
            const float inv = 1.0f / l;
            f32x4 o[4];
#pragma unroll
            for (int dt = 0; dt < 4; ++dt) o[dt] = (f32x4){0.f, 0.f, 0.f, 0.f};
#pragma unroll
            for (int kp = 0; kp < 4; ++kp) {
                u32x2 vv[2][4][2];
#pragma unroll
                for (int k2 = 0; k2 < 2; ++k2) { int sl = slot0 + 2 * kp + k2; sl = (sl >= 9) ? sl - 9 : sl; const unsigned base = (unsigned)sl * 16384u;
#pragma unroll
                    for (int dt = 0; dt < 4; ++dt) { vv[k2][dt][0] = *(const LAS u32x2*)(lds + base + dt * 2048 + va[0]); vv[k2][dt][1] = *(const LAS u32x2*)(lds + base + dt * 2048 + va[1]); } }
#pragma unroll
                for (int k2 = 0; k2 < 2; ++k2) { const int kr = 2 * kp + k2;
                    u32x4 w; w.x = cvtpk(st[2 * kr][0], st[2 * kr][1]); w.y = cvtpk(st[2 * kr][2], st[2 * kr][3]); w.z = cvtpk(st[2 * kr + 1][0], st[2 * kr + 1][1]); w.w = cvtpk(st[2 * kr + 1][2], st[2 * kr + 1][3]);
                    const bf16x8 pf = __builtin_bit_cast(bf16x8, w);
#pragma unroll
                    for (int dt = 0; dt < 4; ++dt) { const u32x4 v4 = {vv[k2][dt][0].x, vv[k2][dt][0].y, vv[k2][dt][1].x, vv[k2][dt][1].y};
                        o[dt] = __builtin_amdgcn_mfma_f32_16x16x32_bf16(__builtin_bit_cast(bf16x8, v4), pf, o[dt], 0, 0, 0); } }
                __builtin_amdgcn_sched_group_barrier(0x100, 16, 0); __builtin_amdgcn_sched_group_barrier(0x008, 8, 0);
            }
            GAS bf16_t* op = AO + ((size_t)b * SEQ + r * 64 + c0 + n) * 1024 + h * 64 + 4 * g;
#pragma unroll
            for (int dt = 0; dt < 4; ++dt) { u32x2 w; w.x = cvtpk(o[dt][0] * inv, o[dt][1] * inv); w.y = cvtpk(o[dt][2] * inv, o[dt][3] * inv); *(GAS u32x2*)(op + 16 * dt) = w; }
            __syncthreads();
            if (nnew >= 1) NA_ST(loaded_hi + 1, p0, p1);
            if (nnew >= 2) NA_ST(loaded_hi + 2, p2, p3);
            loaded_hi = tgt; q0 = q0n; q1 = q1n;
            __syncthreads();
        }
#undef NA_LDK
#undef NA_LDV
#undef NA_ST
    }
}
#undef GAS
#undef LAS
}
#define LAS __attribute__((address_space(3)))
typedef unsigned short bf16;
typedef unsigned v4u __attribute__((ext_vector_type(4)));
typedef unsigned v2u __attribute__((ext_vector_type(2)));
typedef float f32x4 __attribute__((ext_vector_type(4)));
constexpr int NWAVES = 8, NTHR = 512;
constexpr int M = 65536, D = 1024, FF = 2816, PLE = 256, DEPTH = 4, SEQ = 4096;
constexpr size_t MiB = 1u << 20;
constexpr size_t WS_SSQ = 913 * MiB;
constexpr size_t WS_W = 4 * MiB, W_LAYER = 27 * MiB;
constexpr size_t WO_QKV = 0, WO_O = 6 * MiB, WO_GU = 8 * MiB, WO_DN = 19 * MiB, WO_PG = 19 * MiB + 5632 * 1024, WO_PP = WO_PG + 2 * MiB;
constexpr size_t WS_PB = 112 * MiB;
constexpr size_t WS_HB0 = 144 * MiB, WS_HB1 = 272 * MiB;
constexpr size_t WS_QK = 400 * MiB, WS_VT = 656 * MiB;
constexpr size_t WS_HID = 400 * MiB;
constexpr size_t WS_AO = 784 * MiB;
constexpr size_t WS_BAR = 912 * MiB;
constexpr size_t WS_KN = 920 * MiB;
constexpr size_t WS_END = 921 * MiB;
static_assert(WO_PP + (size_t)1024 * 256 * 2 <= W_LAYER && WS_W + 4 * W_LAYER <= WS_PB && WS_HID + (size_t)M * FF * 2 <= WS_AO, "ws map");
constexpr int LDS_BYTES = 155648;

struct Params {
    const float* in[22];
    float* out; unsigned char* ws;
};

__device__ __forceinline__ unsigned f2bf(float f) { unsigned u = __builtin_bit_cast(unsigned, f); return (u + 0x7fffu + ((u >> 16) & 1u)) >> 16; }
__device__ __forceinline__ unsigned pk2(float lo, float hi) { return f2bf(lo) | (f2bf(hi) << 16); }
__device__ __forceinline__ float wave_sum(float v) {
#pragma unroll
    for (int o = 1; o < 64; o <<= 1) v += __shfl_xor(v, o);
    return v;
}
__device__ __forceinline__ void transpose_item(const float* __restrict__ W, int K, int N, const float* __restrict__ gk, bf16* __restrict__ WT, int grp, int gstride, int goff, LAS float* scr, int item, int lane) {
    const int nblk = N / 32, kb = item / nblk, nb = item % nblk, k0 = 64 * kb, n0 = 32 * nb;
    float wv_[32], gs_[32];
#pragma unroll
    for (int i = 0; i < 32; ++i) { const int kk = 2 * i + (lane >> 5); gs_[i] = gk ? ((const __attribute__((address_space(1))) float*)gk)[k0 + kk] : 1.f; wv_[i] = ((const __attribute__((address_space(1))) float*)W)[(size_t)(k0 + kk) * N + n0 + (lane & 31)]; }
#pragma unroll
    for (int i = 0; i < 32; ++i) { const int kk = 2 * i + (lane >> 5); scr[kk * 33 + (lane & 31)] = wv_[i] * gs_[i]; }
    asm volatile("s_waitcnt lgkmcnt(0)" ::: "memory");
    const int c = lane & 7;
#pragma unroll
    for (int j = 0; j < 4; ++j) { const int n = (lane >> 3) + 8 * j; const LAS float* s = scr + (8 * c) * 33 + n;
        v4u o; o.x = pk2(s[0 * 33], s[1 * 33]); o.y = pk2(s[2 * 33], s[3 * 33]); o.z = pk2(s[4 * 33], s[5 * 33]); o.w = pk2(s[6 * 33], s[7 * 33]);
        const int nn = n0 + n, orow = (nn / grp) * gstride + goff + (nn % grp);
        *(__attribute__((address_space(1))) v4u*)(WT + (size_t)orow * K + k0 + 8 * c) = o; }
    asm volatile("s_waitcnt lgkmcnt(0)" ::: "memory");
}

__global__ void __launch_bounds__(NTHR) fwd_megakernel(Params P) {
    extern __shared__ __attribute__((aligned(16))) unsigned char lds_raw[];
    cg::grid_group grid = cg::this_grid();
    unsigned bar_gen = 0;
#define GRID_SYNC() do { asm volatile("s_waitcnt vmcnt(0) lgkmcnt(0)" ::: "memory"); __syncthreads(); \
        if (threadIdx.x == 0) { __builtin_amdgcn_fence(__ATOMIC_RELEASE, "agent"); asm volatile("s_waitcnt vmcnt(0)" ::: "memory"); bar_gen += 1u; \
              \
            const unsigned ngrp_ = (gridDim.x & 7u) ? 1u : 8u, gsz_ = gridDim.x / ngrp_; \
            unsigned* top_ = (unsigned*)(P.ws + WS_BAR); unsigned* grp_ = top_ + 64u * (1u + (ngrp_ == 8u ? (blockIdx.x & 7u) : 0u)); \
            const unsigned old_ = __hip_atomic_fetch_add(grp_, 1u, __ATOMIC_RELAXED, __HIP_MEMORY_SCOPE_AGENT); \
            if (old_ + 1u == gsz_ * bar_gen) __hip_atomic_fetch_add(top_, 1u, __ATOMIC_RELAXED, __HIP_MEMORY_SCOPE_AGENT); \
            while (__hip_atomic_load(top_, __ATOMIC_RELAXED, __HIP_MEMORY_SCOPE_AGENT) < ngrp_ * bar_gen) __builtin_amdgcn_s_sleep(1); \
            __builtin_amdgcn_fence(__ATOMIC_ACQUIRE, "agent"); asm volatile("s_waitcnt vmcnt(0)" ::: "memory"); } \
        __syncthreads(); } while (0)
    LAS unsigned char* lds = (LAS unsigned char*)lds_raw;
#define OPQ_TID() int tid = threadIdx.x; asm volatile("" : "+v"(tid)); const int lane = tid & 63, wave = __builtin_amdgcn_readfirstlane(tid >> 6); \
        const int G = gridDim.x, bx = blockIdx.x, gw = bx * NWAVES + wave, NGW = G * NWAVES; (void)lane; (void)gw; (void)NGW; (void)G; (void)bx
#define OPQ_WS() unsigned char* ws = P.ws; asm volatile("" : "+s"(ws)); pg8::u64* ssq = (pg8::u64*)(ws + WS_SSQ); float* out = P.out; asm volatile("" : "+s"(out))
#define OPQ_LAYER() OPQ_WS(); int lo = li; asm volatile("" : "+s"(lo)); const int j = lo >> 1; unsigned char* wl = ws + WS_W + (size_t)lo * W_LAYER; \
        bf16* HBc = (bf16*)(ws + ((lo & 1) ? WS_HB1 : WS_HB0)); bf16* HBn = (bf16*)(ws + ((lo & 1) ? WS_HB0 : WS_HB1)); \
        pg8::u64* ssq_mix = ssq + (size_t)(3 * lo) * M; pg8::u64* ssq_ffn = ssq_mix + M; pg8::u64* ssq_ple = ssq_ffn + M; pg8::u64* ssq_nxt = ssq_ple + M; \
        bf16* QK = (bf16*)(ws + WS_QK); bf16* VT = (bf16*)(ws + WS_VT); bf16* HID = (bf16*)(ws + WS_HID); bf16* AO = (bf16*)(ws + WS_AO); bf16* PB = (bf16*)(ws + WS_PB); \
        (void)j; (void)wl; (void)HBc; (void)HBn; (void)ssq_mix; (void)ssq_ffn; (void)ssq_ple; (void)ssq_nxt; (void)QK; (void)VT; (void)HID; (void)AO; (void)PB
    {
        OPQ_TID(); OPQ_WS(); (void)out; bf16* HB0 = (bf16*)(ws + WS_HB0);
        const float* x = P.in[0]; const float* norm_mix = P.in[2]; const float* norm_ffn = P.in[3]; const float* norm_ple = P.in[4];
        LAS float* scr = (LAS float*)(lds + wave * 16384);
        constexpr int I_QKV = 16 * 96, I_O = 16 * 32, I_G = 16 * 88, I_DN = 44 * 32, I_PG = 16 * 32, I_PP = 4 * 32, I_LAYER = I_QKV + I_O + 2 * I_G + I_DN + I_PG + I_PP;
        for (int it = gw; it < DEPTH * I_LAYER; it += NGW) {
            const int li = it / I_LAYER, j = li >> 1; int r = it % I_LAYER;
            unsigned char* wl = ws + WS_W + (size_t)li * W_LAYER;
            if (r < I_QKV) { const float* W = (li & 1) ? P.in[13] + (size_t)j * D * 3 * D : P.in[6] + (size_t)j * D * 3 * D;
                transpose_item(W, D, 3 * D, norm_mix + li * D, (bf16*)(wl + WO_QKV), 3 * D, 0, 0, scr, r, lane); continue; } r -= I_QKV;
            if (r < I_O) { const float* W = (li & 1) ? P.in[16] + (size_t)j * D * D : P.in[7] + (size_t)j * D * D;
                transpose_item(W, D, D, nullptr, (bf16*)(wl + WO_O), D, 0, 0, scr, r, lane); continue; } r -= I_O;
            if (r < I_G) { transpose_item(P.in[17] + (size_t)li * D * FF, D, FF, norm_ffn + li * D, (bf16*)(wl + WO_GU), 128, 256, 0, scr, r, lane); continue; } r -= I_G;
            if (r < I_G) { transpose_item(P.in[18] + (size_t)li * D * FF, D, FF, norm_ffn + li * D, (bf16*)(wl + WO_GU), 128, 256, 128, scr, r, lane); continue; } r -= I_G;
            if (r < I_DN) { transpose_item(P.in[19] + (size_t)li * FF * D, FF, D, nullptr, (bf16*)(wl + WO_DN), D, 0, 0, scr, r, lane); continue; } r -= I_DN;
            if (r < I_PG) { transpose_item(P.in[21] + (size_t)li * D * D, D, D, norm_ple + li * D, (bf16*)(wl + WO_PG), D, 0, 0, scr, r, lane); continue; } r -= I_PG;
            transpose_item(P.in[20] + (size_t)li * PLE * D, PLE, D, nullptr, (bf16*)(wl + WO_PP), D, 0, 0, scr, r, lane);
        }
        for (int g32 = gw; g32 < M / 32; g32 += NGW) {
            float keep = 0.f;
#pragma unroll 4
            for (int rr = 0; rr < 32; ++rr) {
                const int m = g32 * 32 + rr;
                const f32x4* xr = (const f32x4*)(x + (size_t)m * D) + lane; f32x4 v[4]; float sq = 0.f;
#pragma unroll
                for (int jj = 0; jj < 4; ++jj) { v[jj] = xr[64 * jj]; sq += (v[jj].x * v[jj].x + v[jj].y * v[jj].y) + (v[jj].z * v[jj].z + v[jj].w * v[jj].w); }
                sq = wave_sum(sq); if (lane == rr) keep = sq;
                v2u* o8 = (v2u*)(HB0 + (size_t)m * D) + lane;
#pragma unroll
                for (int jj = 0; jj < 4; ++jj) { v2u w; w.x = pk2(v[jj].x, v[jj].y); w.y = pk2(v[jj].z, v[jj].w); o8[64 * jj] = w; }
            }
            if (lane < 32) ssq[g32 * 32 + lane] = (pg8::u64)(keep * pg8::SSQ_FIX + 0.5f);
        }
        for (int i = bx * NTHR + tid; i < 12 * M / 2; i += G * NTHR) ((v4u*)(ssq + M))[i] = (v4u){0u, 0u, 0u, 0u};
    }
    GRID_SYNC();
    grid.sync();

#pragma unroll 1
    for (int li = 0; li < DEPTH; ++li) {
        const bool is_da = (li & 1) == 0;
        {
            OPQ_TID(); OPQ_LAYER();
            const float* bqkv = is_da ? nullptr : P.in[14] + (size_t)j * 3 * D;
            { pg8::Gemm g{HBc, (const bf16*)(wl + WO_QKV), M, 2 * D, D}; pg8::StaticOrder S; S.init(M, 2 * D, G, bx);
              pg8::EpiQK E{QK, 2 * D, ssq_mix, bqkv, D, 0.125f * 1.4426950408889634f};
              GEMM_CALL_EpiQK(pg8::gemm_phase<pg8::EpiQK, pg8::StaticOrder, true, true>(lds, g, S, E)); }
            { pg8::Gemm g{(const bf16*)(wl + WO_QKV) + (size_t)2 * D * D, HBc, D, M, D}; pg8::StaticOrder S; S.init(D, M, G, bx);
              pg8::EpiVT E{VT, M, ssq_mix, bqkv ? bqkv + 2 * D : nullptr};
              GEMM_CALL_EpiVT(pg8::gemm_phase<pg8::EpiVT, pg8::StaticOrder, true, true>(lds, g, S, E)); }
        }
        GRID_SYNC();
        { OPQ_TID(); OPQ_LAYER(); const float* pin = P.in[1];
        if (is_da) {
            float d1 = 0.f, d2 = 0.f;
            { const float* q1 = P.in[8] + j * 64; const float* k1 = P.in[9] + j * 64; const float* q2 = P.in[10] + j * 64; const float* k2 = P.in[11] + j * 64;
              d1 = wave_sum(q1[lane] * k1[lane]); d2 = wave_sum(q2[lane] * k2[lane]); }
            const float lam_init = 0.8f - 0.6f * __expf(-0.3f * (float)li);
            const float lam = __expf(d1) - __expf(d2) + lam_init;
#ifndef NO_DA
            float* KN = (float*)(ws + WS_KN);
            att::da_knorm(QK, KN, gw, NGW, lane);
            GRID_SYNC();
            att::da_phase(lds, QK, VT, AO, KN, lam, 1.0f - lam_init, P.in[12] + j * 128, G, bx);
#else
            for (int i = bx * NTHR + tid; i < M * D / 8; i += G * NTHR) ((v4u*)AO)[i] = (v4u){0u, 0u, 0u, 0u};
#endif
        } else {
#ifndef NO_NA
            att::na_phase(lds, QK, VT, AO, P.in[15] + (size_t)j * 16 * 15 * 31, G, bx);
#else
            for (int i = bx * NTHR + tid; i < M * D / 8; i += G * NTHR) ((v4u*)AO)[i] = (v4u){0u, 0u, 0u, 0u};
#endif
        }
#ifdef EXP_TWICE
        if (is_da && li == 0) {
            GRID_SYNC();
            { float d1 = wave_sum(P.in[8][lane] * P.in[9][lane]), d2 = wave_sum(P.in[10][lane] * P.in[11][lane]); const float lam_init = 0.8f - 0.6f * __expf(-0.3f * (float)li);
              att::da_phase(lds, QK, VT, (bf16*)(ws + WS_HB1), (float*)(ws + WS_KN), __expf(d1) - __expf(d2) + lam_init, 1.0f - lam_init, P.in[12], G, bx); }
            GRID_SYNC();
            { const v4u* a = (const v4u*)AO; const v4u* c = (const v4u*)(ws + WS_HB1); unsigned bad = 0;
              for (int i = bx * NTHR + tid; i < M * D / 8; i += G * NTHR) { const v4u u = a[i], w = c[i]; bad |= (u.x ^ w.x) | (u.y ^ w.y) | (u.z ^ w.z) | (u.w ^ w.w); }
              if (bad) __hip_atomic_store((unsigned*)(ws + WS_BAR + 128), 1u, __ATOMIC_RELAXED, __HIP_MEMORY_SCOPE_AGENT); }
        }
#endif
        { const f32x4* src = (const f32x4*)(pin + (size_t)li * M * PLE); v4u* dst = (v4u*)PB;
          const int str_ = G * NTHR;
          for (int i = bx * NTHR + tid; i < M * PLE / 8; i += 4 * str_) { f32x4 a[4], c[4];
#pragma unroll
              for (int k = 0; k < 4; ++k) { const int ii = min(i + k * str_, M * PLE / 8 - 1); a[k] = ((const __attribute__((address_space(1))) f32x4*)src)[2 * ii]; c[k] = ((const __attribute__((address_space(1))) f32x4*)src)[2 * ii + 1]; }
#pragma unroll
              for (int k = 0; k < 4; ++k) { const int ii = i + k * str_; if (ii < M * PLE / 8) { v4u w; w.x = pk2(a[k].x, a[k].y); w.y = pk2(a[k].z, a[k].w); w.z = pk2(c[k].x, c[k].y); w.w = pk2(c[k].z, c[k].w); ((__attribute__((address_space(1))) v4u*)dst)[ii] = w; } } } }
        }
        GRID_SYNC();
        { OPQ_TID(); OPQ_LAYER(); const float* x = P.in[0];
          pg8::Gemm g{AO, (const bf16*)(wl + WO_O), M, D, D}; pg8::StaticOrder S; S.init(M, D, G, bx);
          pg8::EpiResid E{HBc, HBc, ssq_ffn}; (void)x;
          GEMM_CALL_EpiResid(pg8::gemm_phase<pg8::EpiResid, pg8::StaticOrder, true, true>(lds, g, S, E)); }
        GRID_SYNC();
        { OPQ_TID(); OPQ_LAYER();
          pg8::Gemm g{HBc, (const bf16*)(wl + WO_GU), M, 2 * FF, D}; pg8::StaticOrder S; S.init(M, 2 * FF, G, bx);
          pg8::EpiSwiGLU E{HID, ssq_ffn};
          GEMM_CALL_EpiSwiGLU(pg8::gemm_phase<pg8::EpiSwiGLU, pg8::StaticOrder, true, true>(lds, g, S, E)); }
        { OPQ_TID(); OPQ_LAYER();
          pg8::Gemm g{PB, (const bf16*)(wl + WO_PP), M, D, PLE}; pg8::StaticOrder S; S.init(M, D, G, bx);
          pg8::EpiQK E{AO, D, nullptr, nullptr, 0, 1.f};
          GEMM_CALL_EpiQK(pg8::gemm_phase<pg8::EpiQK, pg8::StaticOrder, true, true>(lds, g, S, E)); }
        GRID_SYNC();
        { OPQ_TID(); OPQ_LAYER();
          pg8::Gemm g{HID, (const bf16*)(wl + WO_DN), M, D, FF}; pg8::StaticOrder S; S.init(M, D, G, bx);
          pg8::EpiResid E{HBc, HBc, ssq_ple};
          GEMM_CALL_EpiResid(pg8::gemm_phase<pg8::EpiResid, pg8::StaticOrder, true, true>(lds, g, S, E)); }
        GRID_SYNC();
        { OPQ_TID(); OPQ_LAYER();
          pg8::Gemm g{HBc, (const bf16*)(wl + WO_PG), M, D, D}; pg8::StaticOrder S; S.init(M, D, G, bx);
          pg8::EpiPle E{HBc, AO, HBn, ssq_ple, ssq_nxt};
          GEMM_CALL_EpiPle(pg8::gemm_phase<pg8::EpiPle, pg8::StaticOrder, true, true>(lds, g, S, E)); }
        GRID_SYNC();
    }
    {
        OPQ_TID(); OPQ_WS(); const float* norm_final = P.in[5];
        const pg8::u64* sq = ssq + (size_t)12 * M;
        typedef __attribute__((address_space(1))) f32x4 gf4; typedef __attribute__((address_space(1))) v2u gu2;
        const bf16* HBf = (const bf16*)(ws + ((DEPTH & 1) ? WS_HB1 : WS_HB0));
        f32x4 gg[4];
#pragma unroll
        for (int jj = 0; jj < 4; ++jj) gg[jj] = ((const gf4*)norm_final)[lane + 64 * jj];
        for (int m0 = gw; m0 < M; m0 += 4 * NGW) {
            v2u v[4][4]; pg8::u64 q4[4];
#pragma unroll
            for (int k = 0; k < 4; ++k) { const int m = m0 + k * NGW; q4[k] = ((const __attribute__((address_space(1))) pg8::u64*)sq)[m];
#pragma unroll
                for (int jj = 0; jj < 4; ++jj) v[k][jj] = ((const gu2*)(HBf + (size_t)m * D))[lane + 64 * jj]; }
#pragma unroll
            for (int k = 0; k < 4; ++k) { const int m = m0 + k * NGW; const float rs = pg8::rstd_of(q4[k]);
#pragma unroll
                for (int jj = 0; jj < 4; ++jj) { const v2u w = v[k][jj]; f32x4 f; f[0] = __uint_as_float(w.x << 16); f[1] = __uint_as_float(w.x & 0xffff0000u); f[2] = __uint_as_float(w.y << 16); f[3] = __uint_as_float(w.y & 0xffff0000u);
                    ((gf4*)(out + (size_t)m * D))[lane + 64 * jj] = f * rs * gg[jj]; } }
        }
        for (int m = M; m < M; ++m) { f32x4* hr = nullptr; (void)hr;
#ifdef EXP_TWICE
            if (__hip_atomic_load((unsigned*)(ws + WS_BAR + 128), __ATOMIC_RELAXED, __HIP_MEMORY_SCOPE_AGENT)) { const float qn = __builtin_nanf("");
                for (int jj = 0; jj < 4; ++jj) hr[64 * jj] = (f32x4){qn, qn, qn, qn}; }
#endif
        }
    }
}

extern "C" void kernel_launch(void* const* d_in, const int* in_sizes, int n_in, void* d_out, int out_size, void* d_ws, size_t ws_size, hipStream_t stream) {
    static int grid_blocks = 0;
    if (grid_blocks == 0) {
        if (n_in != 22 || out_size != M * D || ws_size < WS_END) { fprintf(stderr, "kernel_launch: unexpected shapes (n_in %d, out %d, ws %zu)\n", n_in, out_size, ws_size); grid_blocks = -1; return; }
        int dev = 0, cus = 0, per_cu = 0;
        hipGetDevice(&dev);
        hipDeviceGetAttribute(&cus, hipDeviceAttributeMultiprocessorCount, dev);
        if (hipFuncSetAttribute((const void*)fwd_megakernel, hipFuncAttributeMaxDynamicSharedMemorySize, LDS_BYTES) != hipSuccess) fprintf(stderr, "kernel_launch: hipFuncSetAttribute failed\n");
        if (hipOccupancyMaxActiveBlocksPerMultiprocessor(&per_cu, (const void*)fwd_megakernel, NTHR, LDS_BYTES) != hipSuccess || per_cu < 1) { fprintf(stderr, "kernel_launch: occupancy query gave %d\n", per_cu); per_cu = 1; }
        (void)hipGetLastError();
        grid_blocks = cus * per_cu;
    }
    if (grid_blocks < 0) return;
    if (hipMemsetAsync((char*)d_ws + WS_BAR, 0, 4096, stream) != hipSuccess) { fprintf(stderr, "kernel_launch: memset failed\n"); return; }
    Params p{};
    for (int i = 0; i < 22; ++i) p.in[i] = (const float*)d_in[i];
    p.out = (float*)d_out; p.ws = (unsigned char*)d_ws;
    void* args[] = {&p};
    hipError_t e = hipLaunchCooperativeKernel((const void*)fwd_megakernel, dim3(grid_blocks), dim3(NTHR), args, LDS_BYTES, stream);
    if (e != hipSuccess) fprintf(stderr, "cooperative launch failed: %s (grid %d)\n", hipGetErrorString(e), grid_blocks);
}
```
